# Optimizing an MI355X kernel written in HIP

```python
import math
import jax, jax.numpy as jnp
from jax import lax
import numpy as np

D_MODEL = 1024
BATCH = 4
SEQ = 8192
DEPTH = 4

CTX_LEN = 256
GRID_W = 64
N_MIXERS = 2
N_LAYERS_A = (DEPTH + 1) // 2
N_LAYERS_B = DEPTH // 2
BRANCH_WIDTH = D_MODEL
DA_HEAD_DIM = 64
DA_HEADS = BRANCH_WIDTH // (2 * DA_HEAD_DIM)
DA_QK_WIDTH = DA_HEADS * 2 * DA_HEAD_DIM
DA_IN_WIDTH = 2 * DA_QK_WIDTH + 2 * BRANCH_WIDTH
GQ_HEAD_DIM = 128
GQ_HEADS = BRANCH_WIDTH // GQ_HEAD_DIM
GQ_KV_HEADS = 2
GQ_Q_WIDTH = GQ_HEADS * GQ_HEAD_DIM
GQ_KV_WIDTH = GQ_KV_HEADS * GQ_HEAD_DIM
GQ_IN_WIDTH = GQ_Q_WIDTH + 2 * GQ_KV_WIDTH + BRANCH_WIDTH
ROPE_THETA = 10000.0
Q_BLOCK = 128
NORM_EPS = 1e-6

kernel_name = "hybrid_diffattn_gqa_prefix_backbone"


def rms_norm(x, g):
    xf = x.astype(jnp.float32)
    y = xf * lax.rsqrt(jnp.mean(xf * xf, axis=-1, keepdims=True) + NORM_EPS)
    return (y * g.astype(jnp.float32)).astype(x.dtype)


def adaln(cvec, w, b):
    m = jax.nn.silu(cvec) @ w + b
    return jnp.split(m, 3, axis=-1)


def axial_rope_tables(rows, cols, head_dim):
    axis_dim = head_dim // 2
    freqs = ROPE_THETA ** (-jnp.arange(0, axis_dim, 2, dtype=jnp.float32) / axis_dim)
    ang = jnp.concatenate([rows.astype(jnp.float32)[:, None] * freqs,
                           cols.astype(jnp.float32)[:, None] * freqs], axis=-1)
    return jnp.cos(ang), jnp.sin(ang)


def apply_rope(x, cos, sin):
    S, half = cos.shape
    shp = (1, S) + (1,) * (x.ndim - 3) + (half,)
    cs = cos.reshape(shp).astype(x.dtype)
    sn = sin.reshape(shp).astype(x.dtype)
    x1, x2 = jnp.split(x, 2, axis=-1)
    return jnp.concatenate([x1 * cs - x2 * sn, x2 * cs + x1 * sn], axis=-1)


def sweep_attention(q, k, v):
    B, Sq, Hq, Dh = q.shape
    Hkv = k.shape[2]
    G = Hq // Hkv
    Dv = v.shape[-1]
    scale = Dh ** -0.5
    k32 = k.astype(jnp.float32)
    qb = q.reshape(B, Sq // Q_BLOCK, Q_BLOCK, Hkv, G, Dh).transpose(1, 0, 2, 3, 4, 5)

    def one_block(qblk):
        s = jnp.einsum('bqhgd,bkhd->bhgqk', qblk.astype(jnp.float32), k32) * scale
        p = jax.nn.softmax(s, axis=-1)
        return jnp.einsum('bhgqk,bkhd->bqhgd', p.astype(v.dtype), v)

    out = lax.map(one_block, qb)
    return out.transpose(1, 0, 2, 3, 4, 5).reshape(B, Sq, Hq, Dv)


def lambda_init_fn(layer_idx):
    return 0.8 - 0.6 * math.exp(-0.3 * layer_idx)


def diff_attention_mixer(h, hc, w_in, w_out, lam_p, subln_g, lam_init, cos, sin, with_ctx_out):
    B, S, _ = h.shape

    def project(t):
        L = t.shape[1]
        p = t @ w_in
        q, k, v, z = jnp.split(p, [DA_QK_WIDTH, 2 * DA_QK_WIDTH, 2 * DA_QK_WIDTH + BRANCH_WIDTH], axis=-1)
        q = q.reshape(B, L, DA_HEADS, 2, DA_HEAD_DIM)
        k = k.reshape(B, L, DA_HEADS, 2, DA_HEAD_DIM)
        v = v.reshape(B, L, DA_HEADS, 2 * DA_HEAD_DIM)
        return q, k, v, z

    q, k, v, z = project(h)
    qc, kc, vc, zc = project(hc)
    q = apply_rope(q, cos, sin)
    k = apply_rope(k, cos, sin)
    k_all = jnp.concatenate([k, kc], axis=1)
    v_all = jnp.concatenate([v, vc], axis=1)

    lp = lam_p.astype(jnp.float32)
    lam = jnp.exp(jnp.sum(lp[0] * lp[1])) - jnp.exp(jnp.sum(lp[2] * lp[3])) + lam_init

    def diff(qq, kk, vv, gate):
        o1 = sweep_attention(qq[..., 0, :], kk[..., 0, :], vv)
        o2 = sweep_attention(qq[..., 1, :], kk[..., 1, :], vv)
        o = o1 - lam.astype(o1.dtype) * o2
        o = rms_norm(o, subln_g) * (1.0 - lam_init)
        o = o.reshape(o.shape[0], o.shape[1], BRANCH_WIDTH)
        return (o * jax.nn.silu(gate)) @ w_out

    y = diff(q, k_all, v_all, z)
    yc = diff(qc, kc, vc, zc) if with_ctx_out else None
    return y, yc


def gqa_mixer(h, hc, w_in, w_out, qk_g, cos, sin, with_ctx_out):
    B, S, _ = h.shape

    def project(t):
        L = t.shape[1]
        p = t @ w_in
        q, k, v, z = jnp.split(p, [GQ_Q_WIDTH, GQ_Q_WIDTH + GQ_KV_WIDTH, GQ_Q_WIDTH + 2 * GQ_KV_WIDTH], axis=-1)
        q = rms_norm(q.reshape(B, L, GQ_HEADS, GQ_HEAD_DIM), qk_g[0])
        k = rms_norm(k.reshape(B, L, GQ_KV_HEADS, GQ_HEAD_DIM), qk_g[1])
        v = v.reshape(B, L, GQ_KV_HEADS, GQ_HEAD_DIM)
        return q, k, v, z

    q, k, v, z = project(h)
    qc, kc, vc, zc = project(hc)
    q = apply_rope(q, cos, sin)
    k = apply_rope(k, cos, sin)
    k_all = jnp.concatenate([k, kc], axis=1)
    v_all = jnp.concatenate([v, vc], axis=1)

    def attend(qq, kk, vv, gate):
        o = sweep_attention(qq, kk, vv)
        o = o.reshape(o.shape[0], o.shape[1], BRANCH_WIDTH)
        return (o * jax.nn.silu(gate)) @ w_out

    y = attend(q, k_all, v_all, z)
    yc = attend(qc, kc, vc, zc) if with_ctx_out else None
    return y, yc


def setup_inputs(seed: int = 0) -> dict:
    key = jax.random.key(seed)
    ks = jax.random.split(key, 16)
    f32 = jnp.float32
    D = D_MODEL
    s_in = D ** -0.5
    return {
        "x": jax.random.normal(ks[0], (BATCH, SEQ, D), f32),
        "c": jax.random.normal(ks[1], (BATCH, D), f32),
        "ctx": jax.random.normal(ks[2], (BATCH, CTX_LEN, D), f32),
        "c_ctx": jax.random.normal(ks[3], (D,), f32),
        "ada_w": jax.random.normal(ks[4], (DEPTH, D, 3 * D), f32) * (0.5 * s_in),
        "ada_b": jax.random.normal(ks[5], (DEPTH, 3 * D), f32) * 0.01,
        "pre_g": 1.0 + 0.05 * jax.random.normal(ks[6], (DEPTH, D), f32),
        "post_g": 1.0 + 0.05 * jax.random.normal(ks[7], (DEPTH, D), f32),
        "w_out": jax.random.normal(ks[8], (DEPTH, BRANCH_WIDTH, D), f32) * (BRANCH_WIDTH ** -0.5),
        "a_w_in": jax.random.normal(ks[9], (N_LAYERS_A, D, DA_IN_WIDTH), f32) * s_in,
        "a_lambda": jax.random.normal(ks[10], (N_LAYERS_A, 4, DA_HEAD_DIM), f32) * 0.1,
        "a_subln_g": 1.0 + 0.05 * jax.random.normal(ks[11], (N_LAYERS_A, 2 * DA_HEAD_DIM), f32),
        "b_w_in": jax.random.normal(ks[12], (N_LAYERS_B, D, GQ_IN_WIDTH), f32) * s_in,
        "b_qk_g": 1.0 + 0.05 * jax.random.normal(ks[13], (N_LAYERS_B, 2, GQ_HEAD_DIM), f32),
    }


def reference(x, c, ctx, c_ctx, ada_w, ada_b, pre_g, post_g, w_out, a_w_in, a_lambda, a_subln_g, b_w_in, b_qk_g):
    n_tokens = x.shape[1]
    n_rows = n_tokens // GRID_W
    rows = jnp.repeat(jnp.arange(n_rows, dtype=jnp.int32), GRID_W)
    cols = jnp.tile(jnp.arange(GRID_W, dtype=jnp.int32), n_rows)
    cos_a, sin_a = axial_rope_tables(rows, cols, DA_HEAD_DIM)
    cos_b, sin_b = axial_rope_tables(rows, cols, GQ_HEAD_DIM)

    xc = ctx
    for i in range(DEPTH):
        last = i == DEPTH - 1
        shift, scale, gate = adaln(c, ada_w[i], ada_b[i])
        shift, scale, gate = shift[:, None, :], scale[:, None, :], gate[:, None, :]
        cshift, cscale, cgate = adaln(c_ctx, ada_w[i], ada_b[i])
        h = rms_norm(x, pre_g[i]) * (1.0 + scale) + shift
        hc = rms_norm(xc, pre_g[i]) * (1.0 + cscale) + cshift
        j = i // N_MIXERS
        if i % N_MIXERS == 0:
            y, yc = diff_attention_mixer(h, hc, a_w_in[j], w_out[i], a_lambda[j], a_subln_g[j],
                                         lambda_init_fn(i), cos_a, sin_a, not last)
        else:
            y, yc = gqa_mixer(h, hc, b_w_in[j], w_out[i], b_qk_g[j], cos_b, sin_b, not last)
        x = x + gate * rms_norm(y, post_g[i])
        if not last:
            xc = xc + cgate * rms_norm(yc, post_g[i])
    return x
```

```cpp
#include <hip/hip_runtime.h>
#include <hip/hip_bf16.h>
#include <hip/hip_cooperative_groups.h>
#include <cstdio>
#include <cstdint>
namespace cg = cooperative_groups;

#ifndef REP_GEMM
#define REP_GEMM 1
#endif
#ifndef REP_ATTN
#define REP_ATTN 1
#endif
#ifndef REP_OUT
#define REP_OUT 1
#endif
#ifndef REP_ROWS
#define REP_ROWS 1
#endif
#ifndef REP_PREP
#define REP_PREP 1
#endif
#ifndef REP_SYNC
#define REP_SYNC 0
#endif
#ifndef REP_LOOP
#define REP_LOOP 1
#endif
#ifndef REP_EPI
#define REP_EPI 1
#endif
#ifndef MK_COOP
#define MK_COOP 1
#endif

using bf16 = __hip_bfloat16;
using bf16x8 = __attribute__((ext_vector_type(8))) short;
using s16x4  = __attribute__((ext_vector_type(4))) short;
using f32x16 = __attribute__((ext_vector_type(16))) float;
using f32x4  = __attribute__((ext_vector_type(4))) float;
using u32x4  = __attribute__((ext_vector_type(4))) unsigned;
using u32x2  = __attribute__((ext_vector_type(2))) unsigned;

constexpr int NB = 4, SEQ = 8192, CTX = 256, TOK = SEQ + CTX, DM = 1024, NROW = NB * TOK;
constexpr int DEPTH = 4, NA = 4096, NG = 2560;
constexpr float EPS = 1e-6f;
constexpr float LOG2_THETA = 13.287712379549449f;
constexpr int NTHR = 512;
constexpr int NPHASE = 2 + 4 * DEPTH;

struct Params {
  const float *x, *c, *ctx, *c_ctx, *ada_w, *ada_b, *pre_g, *post_g, *w_out, *a_w_in, *a_lambda, *a_subln_g, *b_w_in, *b_qk_g;
  float* out; float* mods; float* xc; bf16* y; unsigned* bar; unsigned* cnt;
  bf16* wtA; bf16* wtB; bf16* wtO; bf16* h; bf16* qkvz;
  int phase_lo, phase_hi;
};

#define SBAR() __builtin_amdgcn_sched_barrier(0)
__device__ __forceinline__ int crow(int r, int hi) { return (r & 3) + 8 * (r >> 2) + 4 * hi; }
__device__ __forceinline__ unsigned cvtpk(float lo, float hi) {
  unsigned r; asm volatile("v_cvt_pk_bf16_f32 %0, %1, %2" : "=v"(r) : "v"(lo), "v"(hi)); return r;
}
__device__ __forceinline__ int opaque_tid() { int t = threadIdx.x; asm volatile("" : "+v"(t)); return t; }
__device__ __forceinline__ void store_wt(void* ptr, u32x4 v) {
  asm volatile("global_store_dwordx4 %0, %1, off sc0 sc1\n\ts_nop 0" :: "v"(ptr), "v"(v) : "memory");
}
__device__ __forceinline__ float silu_f(float v) { return v / (1.f + __expf(-v)); }
__device__ __forceinline__ float bf2f(unsigned short u) { return __uint_as_float(((unsigned)u) << 16); }
__device__ __forceinline__ float wave_sum(float v) {
#pragma unroll
  for (int o = 32; o > 0; o >>= 1) v += __shfl_xor(v, o, 64);
  return v;
}


__device__ __forceinline__ void grid_bar(unsigned* ctr, unsigned target) {
  asm volatile("s_waitcnt vmcnt(0)" ::: "memory");
  __syncthreads();
  if (threadIdx.x == 0) {
    __builtin_amdgcn_fence(__ATOMIC_RELEASE, "agent");
    asm volatile("s_waitcnt vmcnt(0)" ::: "memory");
    __hip_atomic_fetch_add(ctr, 1u, __ATOMIC_RELAXED, __HIP_MEMORY_SCOPE_AGENT);
    while (__hip_atomic_load(ctr, __ATOMIC_RELAXED, __HIP_MEMORY_SCOPE_AGENT) < target) __builtin_amdgcn_s_sleep(2);
    __builtin_amdgcn_fence(__ATOMIC_ACQUIRE, "agent");
    asm volatile("s_waitcnt vmcnt(0)" ::: "memory");
  }
  __syncthreads();
}

__device__ __forceinline__ void phase_prep(const Params& p, char* lds) {
  const int tid = opaque_tid();
  if (blockIdx.x < 192) {
    float* s = (float*)lds;
    float* red = s + 5 * 1024;
    for (int e = tid; e < 5 * 1024; e += NTHR) { int v = e >> 10, k = e & 1023; float cv = v < 4 ? p.c[v * 1024 + k] : p.c_ctx[k]; s[e] = silu_f(cv); }
    __syncthreads();
    for (int it = blockIdx.x; it < 192; it += gridDim.x) {
      const int layer = it / 48, n0 = (it % 48) * 64, col = tid & 63, kg = tid >> 6;
      const float* W = p.ada_w + (size_t)layer * 1024 * 3072 + n0 + col;
      float a0 = 0, a1 = 0, a2 = 0, a3 = 0, a4 = 0;
#pragma unroll 8
      for (int k = kg * 128; k < kg * 128 + 128; ++k) {
        float w = W[(size_t)k * 3072];
        a0 += s[k] * w; a1 += s[1024 + k] * w; a2 += s[2048 + k] * w; a3 += s[3072 + k] * w; a4 += s[4096 + k] * w;
      }
      red[(kg * 5 + 0) * 64 + col] = a0; red[(kg * 5 + 1) * 64 + col] = a1; red[(kg * 5 + 2) * 64 + col] = a2;
      red[(kg * 5 + 3) * 64 + col] = a3; red[(kg * 5 + 4) * 64 + col] = a4;
      __syncthreads();
      if (tid < 320) { int v = tid >> 6; float sum = p.ada_b[layer * 3072 + n0 + col];
        for (int g = 0; g < 8; ++g) sum += red[(g * 5 + v) * 64 + col];
        p.mods[(layer * 5 + v) * 3072 + n0 + col] = sum; }
      __syncthreads();
    }
  }
  __syncthreads();
  float* T = (float*)lds;
  for (int t = blockIdx.x; t < 4352; t += gridDim.x) {
    const float* src; bf16* dst; int N, r;
    if (t < 2048)      { int l = t / 1024; r = t % 1024; N = NA; src = p.a_w_in + (size_t)l * 1024 * NA; dst = p.wtA + (size_t)l * NA * 1024; }
    else if (t < 3328) { int u = t - 2048; int l = u / 640; r = u % 640; N = NG; src = p.b_w_in + (size_t)l * 1024 * NG; dst = p.wtB + (size_t)l * NG * 1024; }
    else               { int u = t - 3328; int l = u / 256; r = u % 256; N = DM; src = p.w_out + (size_t)l * 1024 * DM; dst = p.wtO + (size_t)l * DM * 1024; }
    const int nN = N / 64, kt = r / nN, nt = r % nN;
#pragma unroll
    for (int i = 0; i < 8; ++i) { int k = i * 8 + (tid >> 6), n = tid & 63; T[k * 65 + n] = src[(size_t)(kt * 64 + k) * N + nt * 64 + n]; }
    __syncthreads();
    { int n = tid >> 3, kc = tid & 7; float v[8];
#pragma unroll
      for (int e = 0; e < 8; ++e) v[e] = T[(kc * 8 + e) * 65 + n];
      u32x4 w = {cvtpk(v[0], v[1]), cvtpk(v[2], v[3]), cvtpk(v[4], v[5]), cvtpk(v[6], v[7])};
      *reinterpret_cast<u32x4*>(dst + (size_t)(nt * 64 + n) * 1024 + kt * 64 + kc * 8) = w; }
    __syncthreads();
  }
}

__device__ __forceinline__ void phase_rows(const Params& p, int ld, bool dry = false, const unsigned* ready = nullptr) {
  const int tid = opaque_tid(), wid = tid >> 6, lane = tid & 63;
  const bool last = (ld == DEPTH - 1);
  for (int R = blockIdx.x * 8 + wid; R < NROW; R += gridDim.x * 8) {
    const int b = R / TOK, t = R % TOK; const bool lat = t < SEQ;
    if (last && !lat) continue;
    if (ready != nullptr) {
      if (tid == 0) { while (__hip_atomic_load(ready + (R >> 8), __ATOMIC_RELAXED, __HIP_MEMORY_SCOPE_AGENT) < 8u) __builtin_amdgcn_s_sleep(2); }
      __syncthreads();
    }
    const int mv = lat ? b : 4;
    float xv[16];
    const float* xin = lat ? p.x + ((size_t)b * SEQ + t) * DM : p.ctx + ((size_t)b * CTX + (t - SEQ)) * DM;
    float* xres = lat ? p.out + ((size_t)b * SEQ + t) * DM : p.xc + ((size_t)b * CTX + (t - SEQ)) * DM;
    const float* xold = (ld <= 0) ? xin : xres;
#pragma unroll
    for (int i = 0; i < 4; ++i) { f32x4 v = *reinterpret_cast<const f32x4*>(xold + lane * 4 + 256 * i); xv[4 * i] = v[0]; xv[4 * i + 1] = v[1]; xv[4 * i + 2] = v[2]; xv[4 * i + 3] = v[3]; }
    if (ld >= 0) {
      float yv[16]; float ss = 0;
      const bf16* yr = p.y + (size_t)R * DM;
      u32x2 yq[4];
#pragma unroll
      for (int i = 0; i < 4; ++i) asm volatile("global_load_dwordx2 %0, %1, off sc0 sc1" : "=v"(yq[i]) : "v"(yr + lane * 4 + 256 * i) : "memory");
      asm volatile("s_waitcnt vmcnt(0)" ::: "memory");
#pragma unroll
      for (int i = 0; i < 4; ++i) { const u32x2 v = yq[i];
        yv[4 * i] = __uint_as_float(v[0] << 16); yv[4 * i + 1] = __uint_as_float(v[0] & 0xffff0000u); yv[4 * i + 2] = __uint_as_float(v[1] << 16); yv[4 * i + 3] = __uint_as_float(v[1] & 0xffff0000u); }
#pragma unroll
      for (int e = 0; e < 16; ++e) ss += yv[e] * yv[e];
      ss = wave_sum(ss);
      const float rstd = rsqrtf(ss * (1.f / DM) + EPS);
      const float* gate = p.mods + (ld * 5 + mv) * 3072 + 2048;
      const float* pg = p.post_g + ld * DM;
#pragma unroll
      for (int i = 0; i < 4; ++i) {
        f32x4 g = *reinterpret_cast<const f32x4*>(gate + lane * 4 + 256 * i); f32x4 w = *reinterpret_cast<const f32x4*>(pg + lane * 4 + 256 * i);
        f32x4 o;
#pragma unroll
        for (int e = 0; e < 4; ++e) { xv[4 * i + e] += g[e] * (yv[4 * i + e] * rstd * w[e]); o[e] = xv[4 * i + e]; }
        *reinterpret_cast<f32x4*>((dry ? (float*)(p.y + (size_t)NROW * DM) + (size_t)R * DM : xres) + lane * 4 + 256 * i) = o;
      }
      if (last) continue;
    }
    const int nl = ld + 1;
    float ss = 0;
#pragma unroll
    for (int e = 0; e < 16; ++e) ss += xv[e] * xv[e];
    ss = wave_sum(ss);
    const float rstd = rsqrtf(ss * (1.f / DM) + EPS);
    const float* sh = p.mods + (nl * 5 + mv) * 3072; const float* sc = sh + 1024; const float* pg = p.pre_g + nl * DM;
    bf16* hr = p.h + (size_t)R * DM;
#pragma unroll
    for (int i = 0; i < 4; ++i) {
      f32x4 a = *reinterpret_cast<const f32x4*>(sh + lane * 4 + 256 * i); f32x4 s = *reinterpret_cast<const f32x4*>(sc + lane * 4 + 256 * i);
      f32x4 w = *reinterpret_cast<const f32x4*>(pg + lane * 4 + 256 * i); float hv[4];
#pragma unroll
      for (int e = 0; e < 4; ++e) hv[e] = xv[4 * i + e] * rstd * w[e] * (1.f + s[e]) + a[e];
      u32x2 o = {cvtpk(hv[0], hv[1]), cvtpk(hv[2], hv[3])};
      *reinterpret_cast<u32x2*>(hr + lane * 4 + 256 * i) = o;
    }
  }
}

constexpr int GROW = 144;
constexpr int GTILE = 256 * GROW;
constexpr int GEMM_LDS = 4 * GTILE;
constexpr int GST = 32768;


template <int EPI, int TB>
__device__ __forceinline__ void gemm_epilogue(const Params& p, f32x16 (&acc)[4][TB], int m0, int n0, int t0, bool lat, int layer, char* lds) {
  const int tid = opaque_tid(), wid = tid >> 6, lane = tid & 63, r32 = lane & 31, hi = lane >> 5;
  const int wf = wid & 1, wt = wid >> 1;
  const int nw = n0 + wf * 128;
  if constexpr (EPI == 2) {
    char* const wl = lds + wid * (32 * 272);
#pragma unroll
    for (int tb = 0; tb < TB; ++tb) {
      SBAR();
#pragma unroll
      for (int fb = 0; fb < 4; ++fb)
#pragma unroll
        for (int j = 0; j < 4; ++j) { u32x2 v = {cvtpk(acc[fb][tb][4 * j], acc[fb][tb][4 * j + 1]), cvtpk(acc[fb][tb][4 * j + 2], acc[fb][tb][4 * j + 3])};
          *reinterpret_cast<u32x2*>(wl + r32 * 272 + (fb * 32 + 8 * j + 4 * hi) * 2) = v; }
      asm volatile("s_waitcnt lgkmcnt(0)" ::: "memory"); __builtin_amdgcn_wave_barrier();
      bf16* yb = p.y + (size_t)(m0 + wt * (32 * TB) + tb * 32) * DM + nw;
#pragma unroll
      for (int i = 0; i < 8; ++i) { const int row = 4 * i + (lane >> 4), ch = lane & 15;
        u32x4 v = *reinterpret_cast<const u32x4*>(wl + row * 272 + ch * 16);
        store_wt(yb + (size_t)row * DM + ch * 8, v); }
      asm volatile("s_waitcnt lgkmcnt(0)" ::: "memory"); __builtin_amdgcn_wave_barrier();
    }
  } else {
    constexpr int LD = (EPI == 0) ? NA : NG;
    const bool qk = (EPI == 0) ? (n0 < 2048) : (n0 < 1280);
#pragma unroll
    for (int tb = 0; tb < TB; ++tb) {
      SBAR();
      if constexpr (EPI == 1) {
        if (qk) {
          const float* g = p.b_qk_g + (layer * 2 + (n0 < 1024 ? 0 : 1)) * 128 + hi * 4;
          float ss = 0;
#pragma unroll
          for (int fb = 0; fb < 4; ++fb)
#pragma unroll
            for (int r = 0; r < 16; ++r) ss += acc[fb][tb][r] * acc[fb][tb][r];
          ss += __shfl_xor(ss, 32, 64);
          const float rstd = rsqrtf(ss * (1.f / 128.f) + EPS);
#pragma unroll
          for (int fb = 0; fb < 4; ++fb) {
            SBAR();
#pragma unroll
            for (int j = 0; j < 4; ++j) { const f32x4 gv = *reinterpret_cast<const f32x4*>(g + fb * 32 + 8 * j);
#pragma unroll
              for (int i = 0; i < 4; ++i) acc[fb][tb][4 * j + i] *= rstd * gv[i]; }
          }
        }
      }
      if (qk && lat) {
        const int t = t0 + wt * (32 * TB) + tb * 32 + r32;
        const float prow = (float)(t >> 6), pcol = (float)(t & 63);
        if constexpr (EPI == 0) {
#pragma unroll
          for (int r = 0; r < 16; ++r) {
            SBAR();
            const int fi = (r & 3) + 8 * ((r >> 2) & 1) + 4 * hi;
            const float freq = __builtin_amdgcn_exp2f(-(float)fi * (LOG2_THETA / 16.f));
            float rev = ((r >> 2) < 2 ? prow : pcol) * freq * 0.15915494309189535f; rev -= floorf(rev);
            const float cs = __builtin_amdgcn_cosf(rev), sn = __builtin_amdgcn_sinf(rev);
#pragma unroll
            for (int u = 0; u < 2; ++u) { float x1 = acc[2 * u][tb][r], x2 = acc[2 * u + 1][tb][r];
              acc[2 * u][tb][r] = x1 * cs - x2 * sn; acc[2 * u + 1][tb][r] = x2 * cs + x1 * sn; }
          }
        } else {
#pragma unroll
          for (int r = 0; r < 16; ++r) {
            SBAR();
            const int fi = crow(r, hi);
            const float freq = __builtin_amdgcn_exp2f(-(float)fi * (LOG2_THETA / 32.f)) * 0.15915494309189535f;
            float rv0 = prow * freq; rv0 -= floorf(rv0); float rv1 = pcol * freq; rv1 -= floorf(rv1);
            const float c0 = __builtin_amdgcn_cosf(rv0), s0 = __builtin_amdgcn_sinf(rv0), c1 = __builtin_amdgcn_cosf(rv1), s1 = __builtin_amdgcn_sinf(rv1);
            { float x1 = acc[0][tb][r], x2 = acc[2][tb][r]; acc[0][tb][r] = x1 * c0 - x2 * s0; acc[2][tb][r] = x2 * c0 + x1 * s0; }
            { float x1 = acc[1][tb][r], x2 = acc[3][tb][r]; acc[1][tb][r] = x1 * c1 - x2 * s1; acc[3][tb][r] = x2 * c1 + x1 * s1; }
          }
        }
      }
      SBAR();
      char* const wl = lds + wid * (32 * 272);
#pragma unroll
      for (int fb = 0; fb < 4; ++fb)
#pragma unroll
        for (int j = 0; j < 4; ++j) { u32x2 v = {cvtpk(acc[fb][tb][4 * j], acc[fb][tb][4 * j + 1]), cvtpk(acc[fb][tb][4 * j + 2], acc[fb][tb][4 * j + 3])};
          *reinterpret_cast<u32x2*>(wl + r32 * 272 + (fb * 32 + 8 * j + 4 * hi) * 2) = v; }
      asm volatile("s_waitcnt lgkmcnt(0)" ::: "memory"); __builtin_amdgcn_wave_barrier();
      bf16* ob = p.qkvz + (size_t)(m0 + wt * (32 * TB) + tb * 32) * LD + nw;
#pragma unroll
      for (int i = 0; i < 8; ++i) { const int row = 4 * i + (lane >> 4), ch = lane & 15;
        u32x4 v = *reinterpret_cast<const u32x4*>(wl + row * 272 + ch * 16);
        *reinterpret_cast<u32x4*>(ob + (size_t)row * LD + ch * 8) = v; }
      asm volatile("s_waitcnt lgkmcnt(0)" ::: "memory"); __builtin_amdgcn_wave_barrier();
    }
  }
}

template <int EPI, int TB>
__device__ __forceinline__ void gemm_tile(const Params& p, const bf16* __restrict__ A, const bf16* __restrict__ Wt, int m0, int n0, int layer, char* lds) {
  const int tid = opaque_tid(), wid = tid >> 6, lane = tid & 63, r32 = lane & 31, hi = lane >> 5;
  const int wf = wid & 1, wt = wid >> 1;
  const int mt = m0 >> 8;
  const int t0 = (mt % 33) * 256 + (m0 & 255); const bool lat = (mt % 33) < 32;
  f32x16 acc[4][TB];
#pragma unroll
  for (int i = 0; i < 4; ++i)
#pragma unroll
    for (int tb = 0; tb < TB; ++tb) acc[i][tb] = f32x16{};
  const int gch = (lane & 3) ^ ((lane >> 4) & 3);
  const bf16* Ag = A + (size_t)(m0 + wid * (16 * TB) + (lane >> 2)) * 1024 + gch * 8;
  const bf16* Wg = Wt + (size_t)(n0 + wid * 32 + (lane >> 2)) * 1024 + gch * 8;
  char* const dA = lds + wid * (1024 * TB);
  char* const dW = lds + 16384 + wid * 2048;
#define GISSUE(kt_) do { const int st_ = ((kt_) & 3) * GST; \
      __builtin_amdgcn_global_load_lds((const unsigned*)(Ag + (kt_) * 32), (unsigned*)(dA + st_), 16, 0, 0); \
      if constexpr (TB == 2) __builtin_amdgcn_global_load_lds((const unsigned*)(Ag + 16 * 1024 + (kt_) * 32), (unsigned*)(dA + st_ + 1024), 16, 0, 0); \
      __builtin_amdgcn_global_load_lds((const unsigned*)(Wg + (kt_) * 32), (unsigned*)(dW + st_), 16, 0, 0); \
      __builtin_amdgcn_global_load_lds((const unsigned*)(Wg + 16 * 1024 + (kt_) * 32), (unsigned*)(dW + st_ + 1024), 16, 0, 0); } while (0)
  asm volatile("s_waitcnt vmcnt(0)" ::: "memory");
  GISSUE(0); GISSUE(1); GISSUE(2);
  const int q4 = (r32 >> 2) & 3;
  const int off0 = (hi ^ q4) * 16, off1 = ((2 + hi) ^ q4) * 16;
  const char* const ra = lds + (wt * (32 * TB) + r32) * 64;
  const char* const rw = lds + 16384 + (wf * 128 + r32) * 64;
  for (int kt = 0; kt < 32; ++kt) {
    if constexpr (TB == 2) {
      if (kt < 30) asm volatile("s_waitcnt vmcnt(8)" ::: "memory");
      else if (kt == 30) asm volatile("s_waitcnt vmcnt(4)" ::: "memory");
      else asm volatile("s_waitcnt vmcnt(0)" ::: "memory");
    } else {
      if (kt < 30) asm volatile("s_waitcnt vmcnt(6)" ::: "memory");
      else if (kt == 30) asm volatile("s_waitcnt vmcnt(3)" ::: "memory");
      else asm volatile("s_waitcnt vmcnt(0)" ::: "memory");
    }
    asm volatile("s_waitcnt lgkmcnt(0)" ::: "memory"); __builtin_amdgcn_s_barrier();
    if (kt + 3 < 32) GISSUE(kt + 3);
    const int cur = (kt & 3) * GST;
#pragma unroll
    for (int ks = 0; ks < 2; ++ks) {
      const int ko = ks ? off1 : off0;
      bf16x8 fa[TB], fw[4];
#pragma unroll
      for (int tb = 0; tb < TB; ++tb) fa[tb] = *reinterpret_cast<const bf16x8*>(ra + cur + tb * 32 * 64 + ko);
#pragma unroll
      for (int fb = 0; fb < 4; ++fb) fw[fb] = *reinterpret_cast<const bf16x8*>(rw + cur + fb * 32 * 64 + ko);
#pragma unroll
      for (int fb = 0; fb < 4; ++fb)
#pragma unroll
        for (int tb = 0; tb < TB; ++tb) acc[fb][tb] = __builtin_amdgcn_mfma_f32_32x32x16_bf16(fw[fb], fa[tb], acc[fb][tb], 0, 0, 0);
    }
  }
#undef GISSUE
  asm volatile("s_waitcnt lgkmcnt(0)" ::: "memory"); __builtin_amdgcn_s_barrier();
  gemm_epilogue<EPI, TB>(p, acc, m0, n0, t0, lat, layer, lds);
  if constexpr (EPI == 2) asm volatile("s_waitcnt vmcnt(0)" ::: "memory");
  __syncthreads();
  if constexpr (EPI == 2) { if (tid == 0) __hip_atomic_fetch_add(p.cnt + layer * 132 + mt, (unsigned)TB, __ATOMIC_RELEASE, __HIP_MEMORY_SCOPE_AGENT); }
}

template <int EPI>
__device__ __forceinline__ void gemm_phase(const Params& p, const bf16* __restrict__ A, const bf16* __restrict__ Wt, int N, int layer, bool skip_ctx, char* lds) {
  const int nN = N / 256, nM = skip_ctx ? 128 : 132, ntiles = nM * nN;
  const int GMT = (nN == 4) ? 8 : 4, gtiles = GMT * nN;
  const int G = gridDim.x, bid = blockIdx.x;
  auto tile_mn = [&](int L, int& m0, int& n0) {
    const int grp = L / gtiles, qi = L % gtiles, gsz = min(GMT, nM - grp * GMT);
    const int nt = qi / gsz, lm = grp * GMT + qi % gsz, mt = skip_ctx ? lm + (lm >> 5) : lm;
    m0 = mt * 256; n0 = nt * 256;
  };
  const int nfull = ntiles / G;
  for (int rnd = 0; rnd < nfull; ++rnd) {
    const int L = (G == 256) ? (rnd * 8 + (bid & 7)) * 32 + (bid >> 3) : rnd * G + bid;
    int m0, n0; tile_mn(L, m0, n0);
    gemm_tile<EPI, 2>(p, A, Wt, m0, n0, layer, lds);
  }
  const int left = ntiles - nfull * G;
  for (int u = bid; u < 2 * left; u += G) {
    int m0, n0; tile_mn(nfull * G + (u >> 1), m0, n0);
    gemm_tile<EPI, 1>(p, A, Wt, m0 + (u & 1) * 128, n0, layer, lds);
  }
}

constexpr int KVBLK = 64;
constexpr size_t SHM_V = KVBLK * 128 * 2, SHM_K = KVBLK * 128 * 2, SHM_ATTN = 3 * SHM_V + 3 * SHM_K + 8 * 64 * 4;
constexpr float THR = 8.f;
#define KSWZ(row, colB) ((row) * 256 + ((colB) ^ (((row) & 7) << 4)))

template <int MODE> struct AM;
template <> struct AM<0> { static constexpr int LD = NA, ND0 = 4; static constexpr float SCALE = 0.125f; };
template <> struct AM<1> { static constexpr int LD = NG, ND0 = 8; static constexpr float SCALE = 0.088388347648318440f; };

template <int MODE>
__device__ __forceinline__ void partialSM(f32x16& p0, f32x16& p1, float& m_reg, float& mn, float& alpha) {
  constexpr float SCALE = AM<MODE>::SCALE;
  constexpr float C = SCALE * 1.4426950408889634f;
  float pmax = p0[0];
#pragma unroll
  for (int r = 1; r < 16; ++r) pmax = fmaxf(pmax, p0[r]);
#pragma unroll
  for (int r = 0; r < 16; ++r) pmax = fmaxf(pmax, p1[r]);
  { auto rr = __builtin_amdgcn_permlane32_swap(__float_as_uint(pmax), __float_as_uint(pmax), false, false);
    pmax = fmaxf(__uint_as_float(rr[0]), __uint_as_float(rr[1])); }
  if (__builtin_expect(__all(pmax - m_reg <= THR / SCALE), 1)) { mn = m_reg; alpha = 1.f; }
  else { mn = fmaxf(m_reg, pmax); alpha = __builtin_amdgcn_exp2f((m_reg - mn) * C); m_reg = mn; }
  float mnC = -mn * C;
#pragma unroll
  for (int r = 0; r < 16; ++r) p0[r] = fmaf(p0[r], C, mnC);
#pragma unroll
  for (int r = 0; r < 16; ++r) p1[r] = fmaf(p1[r], C, mnC);
#pragma unroll
  for (int r = 0; r < 16; ++r) p0[r] = __builtin_amdgcn_exp2f(p0[r]);
}
__device__ __forceinline__ void finishSM(f32x16& p0, f32x16& p1, float alpha, float& l_reg, bf16x8& pa0, bf16x8& pa1, bf16x8& pa2, bf16x8& pa3) {
#pragma unroll
  for (int r = 0; r < 16; ++r) p1[r] = __builtin_amdgcn_exp2f(p1[r]);
  float ps = 0;
#pragma unroll
  for (int r = 0; r < 16; ++r) ps += p0[r];
#pragma unroll
  for (int r = 0; r < 16; ++r) ps += p1[r];
  { auto rr = __builtin_amdgcn_permlane32_swap(__float_as_uint(ps), __float_as_uint(ps), false, false);
    ps = __uint_as_float(rr[0]) + __uint_as_float(rr[1]); }
  l_reg = l_reg * alpha + ps;
#define PK4(P, BASE, OUT) do { unsigned a0 = cvtpk(P[BASE + 0], P[BASE + 1]), a1 = cvtpk(P[BASE + 2], P[BASE + 3]);   \
    unsigned b0 = cvtpk(P[BASE + 4], P[BASE + 5]), b1 = cvtpk(P[BASE + 6], P[BASE + 7]);                              \
    auto r0 = __builtin_amdgcn_permlane32_swap(a0, b0, false, false); auto r1 = __builtin_amdgcn_permlane32_swap(a1, b1, false, false); \
    u32x4 w = {r0[0], r1[0], r0[1], r1[1]}; OUT = *reinterpret_cast<bf16x8*>(&w); } while (0)
  PK4(p0, 0, pa0); PK4(p0, 8, pa1); PK4(p1, 0, pa2); PK4(p1, 8, pa3);
#undef PK4
}
template <int MODE>
__device__ __forceinline__ void qkt(f32x16& p0, f32x16& p1, const bf16* Ks, const bf16x8* qr, int r32, int hi, int coff) {
  p0 = f32x16{}; p1 = f32x16{};
#pragma unroll
  for (int d0 = 0; d0 < AM<MODE>::ND0; ++d0) { int cb = (coff + d0 * 16 + hi * 8) * 2;
    bf16x8 b0 = *reinterpret_cast<const bf16x8*>((const char*)Ks + KSWZ(r32, cb));
    bf16x8 b1 = *reinterpret_cast<const bf16x8*>((const char*)Ks + KSWZ(32 + r32, cb));
    p0 = __builtin_amdgcn_mfma_f32_32x32x16_bf16(b0, qr[d0], p0, 0, 0, 0);
    p1 = __builtin_amdgcn_mfma_f32_32x32x16_bf16(b1, qr[d0], p1, 0, 0, 0); }
}
__device__ __forceinline__ int v_st(int k, int c) { const int kk = (k & ~0xC) | ((k & 4) << 1) | ((k & 8) >> 1); return ((kk >> 3) * 4 + (c >> 5)) * 512 + ((kk & 7) * 32 + (c & 31)) * 2; }
__device__ __forceinline__ int v_rd_base(int lane) { return ((lane & 3) << 3) | (((lane >> 2) & 3) << 6) | (((lane >> 4) & 1) << 5) | (((lane >> 5) & 1) << 8); }
constexpr int v_rd_off(int d0, int ks, int half) { return d0 * 512 + ks * 4096 + half * 2048; }
template <int OFF> __device__ __forceinline__ s16x4 tr_read(int vb) {
  s16x4 r; asm volatile("ds_read_b64_tr_b16 %0, %1 offset:%2" : "=&v"(r) : "v"(vb), "i"(OFF) : "memory"); return r;
}
template <int D0> __device__ __forceinline__ void pv_one(f32x16& od, int vb, bf16x8 pa0, bf16x8 pa1, bf16x8 pa2, bf16x8 pa3) {
  const s16x4 l0 = tr_read<v_rd_off(D0, 0, 0)>(vb), h0 = tr_read<v_rd_off(D0, 0, 1)>(vb), l1 = tr_read<v_rd_off(D0, 1, 0)>(vb), h1 = tr_read<v_rd_off(D0, 1, 1)>(vb);
  const s16x4 l2 = tr_read<v_rd_off(D0, 2, 0)>(vb), h2 = tr_read<v_rd_off(D0, 2, 1)>(vb), l3 = tr_read<v_rd_off(D0, 3, 0)>(vb), h3 = tr_read<v_rd_off(D0, 3, 1)>(vb);
  asm volatile("s_waitcnt lgkmcnt(0)" ::: "memory"); SBAR();
#define PK(L, H) (bf16x8){L[0], L[1], L[2], L[3], H[0], H[1], H[2], H[3]}
  od = __builtin_amdgcn_mfma_f32_32x32x16_bf16(pa0, PK(l0, h0), od, 0, 0, 0);
  od = __builtin_amdgcn_mfma_f32_32x32x16_bf16(pa1, PK(l1, h1), od, 0, 0, 0);
  od = __builtin_amdgcn_mfma_f32_32x32x16_bf16(pa2, PK(l2, h2), od, 0, 0, 0);
  od = __builtin_amdgcn_mfma_f32_32x32x16_bf16(pa3, PK(l3, h3), od, 0, 0, 0);
#undef PK
}
__device__ __forceinline__ void pv_d0(f32x16* o, int vb, bf16x8 pa0, bf16x8 pa1, bf16x8 pa2, bf16x8 pa3) {
  pv_one<0>(o[0], vb, pa0, pa1, pa2, pa3); pv_one<1>(o[1], vb, pa0, pa1, pa2, pa3); pv_one<2>(o[2], vb, pa0, pa1, pa2, pa3); pv_one<3>(o[3], vb, pa0, pa1, pa2, pa3);
}
template <int MODE>
__device__ __forceinline__ void pv_sm(f32x16* o, int vb, bf16x8 pa0, bf16x8 pa1, bf16x8 pa2, bf16x8 pa3, f32x16& p0, f32x16& p1, float& m_reg, float& mn, float& alpha) {
  constexpr float SCALE = AM<MODE>::SCALE;
  constexpr float C = SCALE * 1.4426950408889634f;
  pv_one<0>(o[0], vb, pa0, pa1, pa2, pa3);
  float pmax = p0[0];
#pragma unroll
  for (int r = 1; r < 16; ++r) pmax = fmaxf(pmax, p0[r]);
#pragma unroll
  for (int r = 0; r < 16; ++r) pmax = fmaxf(pmax, p1[r]);
  { auto rr = __builtin_amdgcn_permlane32_swap(__float_as_uint(pmax), __float_as_uint(pmax), false, false);
    pmax = fmaxf(__uint_as_float(rr[0]), __uint_as_float(rr[1])); }
  const bool keep = __all(pmax - m_reg <= THR / SCALE);
  mn = keep ? m_reg : fmaxf(m_reg, pmax);
  alpha = keep ? 1.f : __builtin_amdgcn_exp2f((m_reg - mn) * C);
  m_reg = mn;
  const float mnC = -mn * C;
  pv_one<1>(o[1], vb, pa0, pa1, pa2, pa3);
#pragma unroll
  for (int r = 0; r < 16; ++r) p0[r] = fmaf(p0[r], C, mnC);
#pragma unroll
  for (int r = 0; r < 16; ++r) p1[r] = fmaf(p1[r], C, mnC);
  asm volatile("" : "+v"(p0), "+v"(p1));
  pv_one<2>(o[2], vb, pa0, pa1, pa2, pa3);
#pragma unroll
  for (int r = 0; r < 8; ++r) p0[r] = __builtin_amdgcn_exp2f(p0[r]);
  asm volatile("" : "+v"(p0));
  pv_one<3>(o[3], vb, pa0, pa1, pa2, pa3);
#pragma unroll
  for (int r = 8; r < 16; ++r) p0[r] = __builtin_amdgcn_exp2f(p0[r]);
  asm volatile("" : "+v"(p0));
  SBAR();
}

template <int MODE>
__device__ __forceinline__ void epilogue(f32x16* o, const float* rli, const bf16* __restrict__ Zb, bf16* __restrict__ Ob, char* lds, float lam, float osc, const float* __restrict__ subg);
template <int MODE>
__device__ __forceinline__ void attn_body(const bf16* __restrict__ Qb, const bf16* __restrict__ Kh, const bf16* __restrict__ Vh,
                                          const bf16* __restrict__ Zb, bf16* __restrict__ Ob, int seq, char* lds,
                                          float lam, float osc, const float* __restrict__ subg) {
  constexpr int LD = AM<MODE>::LD, ND0 = AM<MODE>::ND0;
  const int tid = opaque_tid(), wid = tid >> 6, lane = tid & 63, r32 = lane & 31, hi = lane >> 5;
  const int qw = (MODE == 0) ? (wid & 3) : wid;
  const int half = (MODE == 0) ? (wid >> 2) : 0;
  const int coff = half * 64;
  bf16* V_lds = (bf16*)lds; bf16* K_lds = (bf16*)(lds + 3 * SHM_V);
  float* ws = (float*)(lds + 3 * SHM_V + 3 * SHM_K) + wid * 64; float* li_l = ws; float* al_l = ws + 32;
  float m_reg = -1e30f, l_reg = 0; f32x16 o[4] = {}; bf16x8 qr[ND0];
  const bf16* Qw = Qb + (long)(qw * 32 + r32) * LD + coff + hi * 8;
#pragma unroll
  for (int d0 = 0; d0 < ND0; ++d0) qr[d0] = *reinterpret_cast<const bf16x8*>(Qw + d0 * 16);
  const int sr = tid >> 4, sc = (tid & 15) * 8, vst0 = v_st(sr, sc), vst1 = v_st(32 + sr, sc);
  const int vb0 = (int)(uintptr_t)V_lds + v_rd_base(lane);
  struct { bf16x8 vs0, vs1, ks0, ks1; } sr_[2];
#define SLOAD(i, k0) do { sr_[i].vs0 = *reinterpret_cast<const bf16x8*>(&Vh[(long)((k0) + sr) * LD + sc]); sr_[i].vs1 = *reinterpret_cast<const bf16x8*>(&Vh[(long)((k0) + 32 + sr) * LD + sc]); \
    sr_[i].ks0 = *reinterpret_cast<const bf16x8*>(&Kh[(long)((k0) + sr) * LD + sc]); sr_[i].ks1 = *reinterpret_cast<const bf16x8*>(&Kh[(long)((k0) + 32 + sr) * LD + sc]); } while (0)
#define SWRITE(b, i) do { *(bf16x8*)((char*)V_lds + (b) * SHM_V + vst0) = sr_[i].vs0;          \
    *(bf16x8*)((char*)V_lds + (b) * SHM_V + vst1) = sr_[i].vs1; int kc = sc * 2;               \
    *(bf16x8*)((char*)K_lds + (b) * SHM_K + KSWZ(sr, kc)) = sr_[i].ks0;                       \
    *(bf16x8*)((char*)K_lds + (b) * SHM_K + KSWZ(32 + sr, kc)) = sr_[i].ks1; } while (0)
#define SWAIT() asm volatile("s_waitcnt vmcnt(4)" ::: "memory")
#define RESC(a) do { if (__any((a) < 1.f)) { if (hi == 0) al_l[r32] = (a); asm volatile("s_waitcnt lgkmcnt(0)" ::: "memory"); \
    _Pragma("unroll") for (int d = 0; d < 4; ++d) _Pragma("unroll") for (int r = 0; r < 16; ++r) o[d][r] *= al_l[crow(r, hi)]; } } while (0)
  f32x16 pA0, pA1, pB0, pB1; float mnA, mnB, alA, alB; bf16x8 pa0, pa1, pa2, pa3; const int NT = seq / KVBLK;
  constexpr int SE = 0, SO = 1;
  SLOAD(SE, 0); asm volatile("s_waitcnt vmcnt(0)" ::: "memory"); SWRITE(0, SE); __syncthreads();
  qkt<MODE>(pA0, pA1, K_lds, qr, r32, hi, coff); partialSM<MODE>(pA0, pA1, m_reg, mnA, alA);
  SLOAD(SO, KVBLK); if (2 < NT) SLOAD(SE, 2 * KVBLK);
  SWAIT(); SWRITE(1, SO); __syncthreads();
  int bP = 0, bC = 1, bN = 2;
  for (int j = 1; j + 1 < NT; j += 2) {
    SBAR(); qkt<MODE>(pB0, pB1, (bf16*)((char*)K_lds + bC * SHM_K), qr, r32, hi, coff);
    finishSM(pA0, pA1, alA, l_reg, pa0, pa1, pa2, pa3); SBAR();
    SLOAD(SO, (j + 2) * KVBLK); SBAR();
    pv_sm<MODE>(o, vb0 + bP * (int)SHM_V, pa0, pa1, pa2, pa3, pB0, pB1, m_reg, mnB, alB);
    SWAIT(); SWRITE(bN, SE);
    RESC(alB); __syncthreads();
    { const int t_ = bP; bP = bC; bC = bN; bN = t_; }
    SBAR(); qkt<MODE>(pA0, pA1, (bf16*)((char*)K_lds + bC * SHM_K), qr, r32, hi, coff);
    finishSM(pB0, pB1, alB, l_reg, pa0, pa1, pa2, pa3); SBAR();
    if (j + 3 < NT) SLOAD(SE, (j + 3) * KVBLK); SBAR();
    pv_sm<MODE>(o, vb0 + bP * (int)SHM_V, pa0, pa1, pa2, pa3, pA0, pA1, m_reg, mnA, alA);
    SWAIT(); SWRITE(bN, SO);
    RESC(alA); __syncthreads();
    { const int t_ = bP; bP = bC; bC = bN; bN = t_; }
  }
  SBAR(); qkt<MODE>(pB0, pB1, (bf16*)((char*)K_lds + bC * SHM_K), qr, r32, hi, coff);
  finishSM(pA0, pA1, alA, l_reg, pa0, pa1, pa2, pa3); SBAR();
  pv_d0(o, vb0 + bP * (int)SHM_V, pa0, pa1, pa2, pa3); partialSM<MODE>(pB0, pB1, m_reg, mnB, alB);
  RESC(alB);
  finishSM(pB0, pB1, alB, l_reg, pa0, pa1, pa2, pa3); SBAR();
  pv_d0(o, vb0 + bC * (int)SHM_V, pa0, pa1, pa2, pa3);
  if (hi == 0) li_l[r32] = l_reg; asm volatile("s_waitcnt lgkmcnt(0)" ::: "memory");
  float rli[16];
#pragma unroll
  for (int r = 0; r < 16; ++r) rli[r] = __builtin_amdgcn_rcpf(li_l[crow(r, hi)]);
  __syncthreads();
  epilogue<MODE>(o, rli, Zb, Ob, lds, lam, osc, subg);
}

template <int MODE>
__device__ __forceinline__ void epilogue(f32x16* o, const float* rli, const bf16* __restrict__ Zb, bf16* __restrict__ Ob, char* lds, float lam, float osc, const float* __restrict__ subg) {
  constexpr int LD = AM<MODE>::LD;
  const int tid = opaque_tid(), wid = tid >> 6, lane = tid & 63, r32 = lane & 31, hi = lane >> 5;
  float* const Y = (float*)lds;
#pragma unroll
  for (int r = 0; r < 16; ++r) { float* yr = Y + (wid * 32 + crow(r, hi)) * 132 + r32;
#pragma unroll
    for (int d0 = 0; d0 < 4; ++d0) yr[d0 * 32] = o[d0][r] * rli[r]; }
  if constexpr (MODE == 1) { asm volatile("s_waitcnt lgkmcnt(0)" ::: "memory"); __builtin_amdgcn_wave_barrier(); }
  else __syncthreads();
  const int c = lane & 15, rsub = lane >> 4;
  constexpr int NIT = (MODE == 1) ? 8 : 4;
  float sg[8];
  if constexpr (MODE == 0) {
#pragma unroll
    for (int e = 0; e < 8; ++e) sg[e] = subg[c * 8 + e] * osc;
  }
#pragma unroll
  for (int i = 0; i < NIT; ++i) {
    SBAR();
    const int row = ((MODE == 1) ? wid * 32 : wid * 16) + i * 4 + rsub;
    const f32x4 a0 = *reinterpret_cast<const f32x4*>(Y + row * 132 + c * 8), a1 = *reinterpret_cast<const f32x4*>(Y + row * 132 + c * 8 + 4);
    float v[8] = {a0[0], a0[1], a0[2], a0[3], a1[0], a1[1], a1[2], a1[3]};
    const u32x4 zz = *reinterpret_cast<const u32x4*>(Zb + (long)row * LD + c * 8);
    if constexpr (MODE == 0) {
      const f32x4 b0 = *reinterpret_cast<const f32x4*>(Y + (128 + row) * 132 + c * 8), b1 = *reinterpret_cast<const f32x4*>(Y + (128 + row) * 132 + c * 8 + 4);
      const float w[8] = {b0[0], b0[1], b0[2], b0[3], b1[0], b1[1], b1[2], b1[3]};
      float ss = 0;
#pragma unroll
      for (int e = 0; e < 8; ++e) { v[e] -= lam * w[e]; ss += v[e] * v[e]; }
#pragma unroll
      for (int sft = 8; sft > 0; sft >>= 1) ss += __shfl_xor(ss, sft, 64);
      const float rstd = rsqrtf(ss * (1.f / 128.f) + EPS);
#pragma unroll
      for (int e = 0; e < 8; ++e) v[e] *= rstd * sg[e];
    }
#pragma unroll
    for (int e = 0; e < 4; ++e) { v[2 * e] *= silu_f(__uint_as_float(zz[e] << 16)); v[2 * e + 1] *= silu_f(__uint_as_float(zz[e] & 0xffff0000u)); }
    const u32x4 ov = {cvtpk(v[0], v[1]), cvtpk(v[2], v[3]), cvtpk(v[4], v[5]), cvtpk(v[6], v[7])};
    *reinterpret_cast<u32x4*>(Ob + (long)row * DM + c * 8) = ov;
  }
  __syncthreads();
#undef SLOAD
#undef SWRITE
#undef SWAIT
#undef RESC
}

__device__ __forceinline__ void attn_phase_da(const Params& p, int layer, char* lds) {
  const int j = layer >> 1; const bool last = (layer == DEPTH - 1);
  const float lam_init = 0.8f - 0.6f * __expf(-0.3f * (float)layer);
  const float* lp = p.a_lambda + j * 4 * 64;
  float s1 = 0, s2 = 0;
  for (int e = 0; e < 64; ++e) { s1 += lp[e] * lp[64 + e]; s2 += lp[128 + e] * lp[192 + e]; }
  const float lam = __expf(s1) - __expf(s2) + lam_init;
  const float* subg = p.a_subln_g + j * 128;
  const bf16* base = p.qkvz; bf16* og = p.h;
  const int bid = blockIdx.x, G = gridDim.x;
  const int nit = last ? 2048 : 2048 + 64;
  for (int it = bid; it < nit; it += G) {
    int grp, qb, seq; long R0, K0;
    if (it < 2048) {
      if (G == 256) { const int rnd = it >> 8, xcd = bid & 7, slot = bid >> 3; grp = xcd + 8 * (rnd >> 1); qb = (rnd & 1) * 32 + slot; }
      else { grp = it >> 6; qb = it & 63; }
      K0 = (long)(grp >> 3) * TOK; R0 = K0 + qb * 128; seq = TOK;
    } else { const int u = it - 2048; grp = u >> 1; qb = u & 1; K0 = (long)(grp >> 3) * TOK + SEQ; R0 = K0 + qb * 128; seq = CTX; }
    const int hd = grp & 7;
    attn_body<0>(base + R0 * NA + hd * 128, base + K0 * NA + 1024 + hd * 128, base + K0 * NA + 2048 + hd * 128,
                 base + R0 * NA + 3072 + hd * 128, og + R0 * DM + hd * 128, seq, lds, lam, 1.f - lam_init, subg);
  }
}
__device__ __forceinline__ void attn_phase_gq(const Params& p, int layer, char* lds) {
  const bool last = (layer == DEPTH - 1);
  const bf16* base = p.qkvz; bf16* og = p.h;
  const int bid = blockIdx.x, G = gridDim.x;
  const int nit = last ? 1024 : 1024 + 32;
  for (int it = bid; it < nit; it += G) {
    int b, hd, seq; long R0, K0;
    if (it < 1024) {
      int grp, idx;
      if (G == 256) { const int rnd = it >> 8; grp = bid & 7; idx = rnd * 32 + (bid >> 3); }
      else { grp = it >> 7; idx = it & 127; }
      b = grp >> 1; hd = (grp & 1) * 4 + (idx >> 5); K0 = (long)b * TOK; R0 = K0 + (idx & 31) * 256; seq = TOK;
    } else { const int u = it - 1024; b = u >> 3; hd = u & 7; K0 = (long)b * TOK + SEQ; R0 = K0; seq = CTX; }
    const int kvh = hd >> 2;
    attn_body<1>(base + R0 * NG + hd * 128, base + K0 * NG + 1024 + kvh * 128, base + K0 * NG + 1280 + kvh * 128,
                 base + R0 * NG + 1536 + hd * 128, og + R0 * DM + hd * 128, seq, lds, 0.f, 0.f, nullptr);
  }
}

__global__ __launch_bounds__(NTHR) void mega(Params p) {
  extern __shared__ __attribute__((aligned(16))) char lds[];
  if (blockIdx.x == 0 && threadIdx.x == 0) __hip_atomic_store(p.bar, 0u, __ATOMIC_RELAXED, __HIP_MEMORY_SCOPE_AGENT);
  if (blockIdx.x == 0) { for (int i = threadIdx.x; i < DEPTH * 132; i += NTHR) __hip_atomic_store(p.cnt + i, 0u, __ATOMIC_RELAXED, __HIP_MEMORY_SCOPE_AGENT); }
  unsigned nbar = 0;
  for (int ph = p.phase_lo; ph < p.phase_hi; ++ph) {
    if (ph >= 2 && ((ph - 2) & 3) == 3) continue;
    if (ph == p.phase_lo + 1) cg::this_grid().sync();
    else if (ph > p.phase_lo) { ++nbar; grid_bar(p.bar, nbar * gridDim.x); }
    if (ph == 0) { for (int rep = 0; rep < REP_PREP; ++rep) { if (rep) cg::this_grid().sync(); phase_prep(p, lds); }
                   for (int rep = 0; rep < REP_SYNC; ++rep) cg::this_grid().sync(); }
    else if (ph == 1) phase_rows(p, -1);
    else {
      const int layer = (ph - 2) >> 2, sub = (ph - 2) & 3, j = layer >> 1; const bool da = (layer & 1) == 0;
      if (sub == 0) { for (int rep = 0; rep < REP_GEMM; ++rep) { if (rep) cg::this_grid().sync();
                      if (da) gemm_phase<0>(p, p.h, p.wtA + (size_t)j * NA * 1024, NA, j, false, lds);
                      else    gemm_phase<1>(p, p.h, p.wtB + (size_t)j * NG * 1024, NG, j, false, lds); } }
      else if (sub == 1) { for (int rep = 0; rep < REP_ATTN; ++rep) { if (rep) cg::this_grid().sync();
                      if (da) attn_phase_da(p, layer, lds); else attn_phase_gq(p, layer, lds); } }
      else if (sub == 2) { gemm_phase<2>(p, p.h, p.wtO + (size_t)layer * DM * 1024, DM, layer, layer == DEPTH - 1, lds);
                           __syncthreads(); phase_rows(p, layer, false, p.cnt + layer * 132); }
      else { for (int rep = REP_ROWS - 1; rep >= 0; --rep) { phase_rows(p, layer, rep > 0); if (rep) cg::this_grid().sync(); } }
    }
  }
}

extern "C" void kernel_launch(void* const* d_in, const int* in_sizes, int n_in, void* d_out, int out_size, void* d_ws, size_t ws_size, hipStream_t stream) {
  constexpr size_t DYN = GEMM_LDS > SHM_ATTN ? GEMM_LDS : SHM_ATTN;
  static int grid_blocks = 0;
  if (!grid_blocks) {
    if (hipFuncSetAttribute((const void*)mega, hipFuncAttributeMaxDynamicSharedMemorySize, (int)DYN) != hipSuccess) { fprintf(stderr, "hipFuncSetAttribute failed\n"); return; }
    int dev = 0, cus = 0, per_cu = 0;
    hipGetDevice(&dev);
    hipDeviceGetAttribute(&cus, hipDeviceAttributeMultiprocessorCount, dev);
    hipOccupancyMaxActiveBlocksPerMultiprocessor(&per_cu, mega, NTHR, DYN);
    if (per_cu < 1) { fprintf(stderr, "occupancy 0\n"); return; }
    grid_blocks = cus;
  }
  Params p{};
  p.x = (const float*)d_in[0]; p.c = (const float*)d_in[1]; p.ctx = (const float*)d_in[2]; p.c_ctx = (const float*)d_in[3];
  p.ada_w = (const float*)d_in[4]; p.ada_b = (const float*)d_in[5]; p.pre_g = (const float*)d_in[6]; p.post_g = (const float*)d_in[7];
  p.w_out = (const float*)d_in[8]; p.a_w_in = (const float*)d_in[9]; p.a_lambda = (const float*)d_in[10]; p.a_subln_g = (const float*)d_in[11];
  p.b_w_in = (const float*)d_in[12]; p.b_qk_g = (const float*)d_in[13];
  p.out = (float*)d_out;
  char* w = (char*)d_ws; size_t off = 0;
  auto take = [&](size_t bytes) { char* r = w + off; off += (bytes + 255) / 256 * 256; return r; };
  p.bar  = (unsigned*)take(256);
  p.cnt  = (unsigned*)take((size_t)DEPTH * 132 * 4);
  p.mods = (float*)take((size_t)DEPTH * 5 * 3072 * 4);
  p.xc   = (float*)take((size_t)NB * CTX * DM * 4);
  p.wtA  = (bf16*)take((size_t)2 * NA * 1024 * 2);
  p.wtB  = (bf16*)take((size_t)2 * NG * 1024 * 2);
  p.wtO  = (bf16*)take((size_t)4 * DM * 1024 * 2);
  p.h    = (bf16*)take((size_t)NROW * DM * 2);
  p.qkvz = (bf16*)take((size_t)NROW * NA * 2);
  p.y    = p.qkvz;
  if (off > ws_size) { fprintf(stderr, "workspace too small: need %zu have %zu\n", off, ws_size); return; }
#if MK_COOP
  p.phase_lo = 0; p.phase_hi = NPHASE;
  void* args[] = {&p};
  hipError_t e = hipLaunchCooperativeKernel((void*)mega, dim3(grid_blocks), dim3(NTHR), args, DYN, stream);
  if (e != hipSuccess) fprintf(stderr, "cooperative launch failed: %s (grid %d)\n", hipGetErrorString(e), grid_blocks);
#else
  for (int ph = 0; ph < NPHASE; ++ph) {
    p.phase_lo = ph; p.phase_hi = ph + 1;
    hipLaunchKernelGGL(mega, dim3(grid_blocks), dim3(NTHR), DYN, stream, p);
  }
#endif
}
```

```cpp
#include <hip/hip_runtime.h>
#include <hip/hip_bf16.h>
#include <hip/hip_cooperative_groups.h>
#include <cstdio>
#include <cstdint>
namespace cg = cooperative_groups;

#ifndef REP_GEMM
#define REP_GEMM 1
#endif
#ifndef REP_ATTN
#define REP_ATTN 1
#endif
#ifndef REP_OUT
#define REP_OUT 1
#endif
#ifndef REP_ROWS
#define REP_ROWS 1
#endif
#ifndef REP_PREP
#define REP_PREP 1
#endif
#ifndef REP_SYNC
#define REP_SYNC 0
#endif
#ifndef REP_LOOP
#define REP_LOOP 1
#endif
#ifndef REP_EPI
#define REP_EPI 1
#endif
#ifndef MK_COOP
#define MK_COOP 1
#endif

using bf16 = __hip_bfloat16;
using bf16x8 = __attribute__((ext_vector_type(8))) short;
using s16x4  = __attribute__((ext_vector_type(4))) short;
using f32x16 = __attribute__((ext_vector_type(16))) float;
using f32x4  = __attribute__((ext_vector_type(4))) float;
using u32x4  = __attribute__((ext_vector_type(4))) unsigned;
using u32x2  = __attribute__((ext_vector_type(2))) unsigned;

constexpr int NB = 4, SEQ = 8192, CTX = 256, TOK = SEQ + CTX, DM = 1024, NROW = NB * TOK;
constexpr int DEPTH = 4, NA = 4096, NG = 2560;
constexpr float EPS = 1e-6f;
constexpr float LOG2_THETA = 13.287712379549449f;
constexpr int NTHR = 512;
constexpr int NPHASE = 2 + 4 * DEPTH;

struct Params {
  const float *x, *c, *ctx, *c_ctx, *ada_w, *ada_b, *pre_g, *post_g, *w_out, *a_w_in, *a_lambda, *a_subln_g, *b_w_in, *b_qk_g;
  float* out; float* mods; float* xc; bf16* y; unsigned* bar; unsigned* cnt;
  bf16* wtA; bf16* wtB; bf16* wtO; bf16* h; bf16* qkvz;
  int phase_lo, phase_hi;
};

#define SBAR() __builtin_amdgcn_sched_barrier(0)
__device__ __forceinline__ int crow(int r, int hi) { return (r & 3) + 8 * (r >> 2) + 4 * hi; }
__device__ __forceinline__ unsigned cvtpk(float lo, float hi) {
  unsigned r; asm volatile("v_cvt_pk_bf16_f32 %0, %1, %2" : "=v"(r) : "v"(lo), "v"(hi)); return r;
}
__device__ __forceinline__ int opaque_tid() { int t = threadIdx.x; asm volatile("" : "+v"(t)); return t; }
__device__ __forceinline__ void store_wt(void* ptr, u32x4 v) {
  asm volatile("global_store_dwordx4 %0, %1, off sc0 sc1\n\ts_nop 0" :: "v"(ptr), "v"(v) : "memory");
}
__device__ __forceinline__ float silu_f(float v) { return v / (1.f + __expf(-v)); }
__device__ __forceinline__ float bf2f(unsigned short u) { return __uint_as_float(((unsigned)u) << 16); }
__device__ __forceinline__ float wave_sum(float v) {
#pragma unroll
  for (int o = 32; o > 0; o >>= 1) v += __shfl_xor(v, o, 64);
  return v;
}


__device__ __forceinline__ void grid_bar(unsigned* ctr, unsigned target) {
  asm volatile("s_waitcnt vmcnt(0)" ::: "memory");
  __syncthreads();
  if (threadIdx.x == 0) {
    __builtin_amdgcn_fence(__ATOMIC_RELEASE, "agent");
    asm volatile("s_waitcnt vmcnt(0)" ::: "memory");
    __hip_atomic_fetch_add(ctr, 1u, __ATOMIC_RELAXED, __HIP_MEMORY_SCOPE_AGENT);
    while (__hip_atomic_load(ctr, __ATOMIC_RELAXED, __HIP_MEMORY_SCOPE_AGENT) < target) __builtin_amdgcn_s_sleep(2);
    __builtin_amdgcn_fence(__ATOMIC_ACQUIRE, "agent");
    asm volatile("s_waitcnt vmcnt(0)" ::: "memory");
  }
  __syncthreads();
}

__device__ __forceinline__ void phase_prep(const Params& p, char* lds) {
  const int tid = opaque_tid();
  if (blockIdx.x < 192) {
    float* s = (float*)lds;
    float* red = s + 5 * 1024;
    for (int e = tid; e < 5 * 1024; e += NTHR) { int v = e >> 10, k = e & 1023; float cv = v < 4 ? p.c[v * 1024 + k] : p.c_ctx[k]; s[e] = silu_f(cv); }
    __syncthreads();
    for (int it = blockIdx.x; it < 192; it += gridDim.x) {
      const int layer = it / 48, n0 = (it % 48) * 64, col = tid & 63, kg = tid >> 6;
      const float* W = p.ada_w + (size_t)layer * 1024 * 3072 + n0 + col;
      float a0 = 0, a1 = 0, a2 = 0, a3 = 0, a4 = 0;
#pragma unroll 8
      for (int k = kg * 128; k < kg * 128 + 128; ++k) {
        float w = W[(size_t)k * 3072];
        a0 += s[k] * w; a1 += s[1024 + k] * w; a2 += s[2048 + k] * w; a3 += s[3072 + k] * w; a4 += s[4096 + k] * w;
      }
      red[(kg * 5 + 0) * 64 + col] = a0; red[(kg * 5 + 1) * 64 + col] = a1; red[(kg * 5 + 2) * 64 + col] = a2;
      red[(kg * 5 + 3) * 64 + col] = a3; red[(kg * 5 + 4) * 64 + col] = a4;
      __syncthreads();
      if (tid < 320) { int v = tid >> 6; float sum = p.ada_b[layer * 3072 + n0 + col];
        for (int g = 0; g < 8; ++g) sum += red[(g * 5 + v) * 64 + col];
        p.mods[(layer * 5 + v) * 3072 + n0 + col] = sum; }
      __syncthreads();
    }
  }
  __syncthreads();
  float* T = (float*)lds;
  for (int t = blockIdx.x; t < 4352; t += gridDim.x) {
    const float* src; bf16* dst; int N, r;
    if (t < 2048)      { int l = t / 1024; r = t % 1024; N = NA; src = p.a_w_in + (size_t)l * 1024 * NA; dst = p.wtA + (size_t)l * NA * 1024; }
    else if (t < 3328) { int u = t - 2048; int l = u / 640; r = u % 640; N = NG; src = p.b_w_in + (size_t)l * 1024 * NG; dst = p.wtB + (size_t)l * NG * 1024; }
    else               { int u = t - 3328; int l = u / 256; r = u % 256; N = DM; src = p.w_out + (size_t)l * 1024 * DM; dst = p.wtO + (size_t)l * DM * 1024; }
    const int nN = N / 64, kt = r / nN, nt = r % nN;
#pragma unroll
    for (int i = 0; i < 8; ++i) { int k = i * 8 + (tid >> 6), n = tid & 63; T[k * 65 + n] = src[(size_t)(kt * 64 + k) * N + nt * 64 + n]; }
    __syncthreads();
    { int n = tid >> 3, kc = tid & 7; float v[8];
#pragma unroll
      for (int e = 0; e < 8; ++e) v[e] = T[(kc * 8 + e) * 65 + n];
      u32x4 w = {cvtpk(v[0], v[1]), cvtpk(v[2], v[3]), cvtpk(v[4], v[5]), cvtpk(v[6], v[7])};
      *reinterpret_cast<u32x4*>(dst + (size_t)(nt * 64 + n) * 1024 + kt * 64 + kc * 8) = w; }
    __syncthreads();
  }
}

__device__ __forceinline__ void phase_rows(const Params& p, int ld, bool dry = false, const unsigned* ready = nullptr) {
  const int tid = opaque_tid(), wid = tid >> 6, lane = tid & 63;
  const bool last = (ld == DEPTH - 1);
  for (int R = blockIdx.x * 8 + wid; R < NROW; R += gridDim.x * 8) {
    const int b = R / TOK, t = R % TOK; const bool lat = t < SEQ;
    if (last && !lat) continue;
    if (ready != nullptr) {
      if (tid == 0) { while (__hip_atomic_load(ready + (R >> 8), __ATOMIC_RELAXED, __HIP_MEMORY_SCOPE_AGENT) < 8u) __builtin_amdgcn_s_sleep(2); }
      __syncthreads();
    }
    const int mv = lat ? b : 4;
    float xv[16];
    const float* xin = lat ? p.x + ((size_t)b * SEQ + t) * DM : p.ctx + ((size_t)b * CTX + (t - SEQ)) * DM;
    float* xres = lat ? p.out + ((size_t)b * SEQ + t) * DM : p.xc + ((size_t)b * CTX + (t - SEQ)) * DM;
    const float* xold = (ld <= 0) ? xin : xres;
#pragma unroll
    for (int i = 0; i < 4; ++i) { f32x4 v = *reinterpret_cast<const f32x4*>(xold + lane * 4 + 256 * i); xv[4 * i] = v[0]; xv[4 * i + 1] = v[1]; xv[4 * i + 2] = v[2]; xv[4 * i + 3] = v[3]; }
    if (ld >= 0) {
      float yv[16]; float ss = 0;
      const bf16* yr = p.y + (size_t)R * DM;
      u32x2 yq[4];
      asm volatile("global_load_dwordx2 %0, %4, off sc0 sc1\n\tglobal_load_dwordx2 %1, %4, off offset:512 sc0 sc1\n\t"
                   "global_load_dwordx2 %2, %4, off offset:1024 sc0 sc1\n\tglobal_load_dwordx2 %3, %4, off offset:1536 sc0 sc1\n\ts_waitcnt vmcnt(0)"
                   : "=&v"(yq[0]), "=&v"(yq[1]), "=&v"(yq[2]), "=&v"(yq[3]) : "v"(yr + lane * 4) : "memory");
#pragma unroll
      for (int i = 0; i < 4; ++i) { const u32x2 v = yq[i];
        yv[4 * i] = __uint_as_float(v[0] << 16); yv[4 * i + 1] = __uint_as_float(v[0] & 0xffff0000u); yv[4 * i + 2] = __uint_as_float(v[1] << 16); yv[4 * i + 3] = __uint_as_float(v[1] & 0xffff0000u); }
#pragma unroll
      for (int e = 0; e < 16; ++e) ss += yv[e] * yv[e];
      ss = wave_sum(ss);
      const float rstd = rsqrtf(ss * (1.f / DM) + EPS);
      const float* gate = p.mods + (ld * 5 + mv) * 3072 + 2048;
      const float* pg = p.post_g + ld * DM;
#pragma unroll
      for (int i = 0; i < 4; ++i) {
        f32x4 g = *reinterpret_cast<const f32x4*>(gate + lane * 4 + 256 * i); f32x4 w = *reinterpret_cast<const f32x4*>(pg + lane * 4 + 256 * i);
        f32x4 o;
#pragma unroll
        for (int e = 0; e < 4; ++e) { xv[4 * i + e] += g[e] * (yv[4 * i + e] * rstd * w[e]); o[e] = xv[4 * i + e]; }
        *reinterpret_cast<f32x4*>((dry ? (float*)(p.y + (size_t)NROW * DM) + (size_t)R * DM : xres) + lane * 4 + 256 * i) = o;
      }
      if (last) continue;
    }
    const int nl = ld + 1;
    float ss = 0;
#pragma unroll
    for (int e = 0; e < 16; ++e) ss += xv[e] * xv[e];
    ss = wave_sum(ss);
    const float rstd = rsqrtf(ss * (1.f / DM) + EPS);
    const float* sh = p.mods + (nl * 5 + mv) * 3072; const float* sc = sh + 1024; const float* pg = p.pre_g + nl * DM;
    bf16* hr = p.h + (size_t)R * DM;
#pragma unroll
    for (int i = 0; i < 4; ++i) {
      f32x4 a = *reinterpret_cast<const f32x4*>(sh + lane * 4 + 256 * i); f32x4 s = *reinterpret_cast<const f32x4*>(sc + lane * 4 + 256 * i);
      f32x4 w = *reinterpret_cast<const f32x4*>(pg + lane * 4 + 256 * i); float hv[4];
#pragma unroll
      for (int e = 0; e < 4; ++e) hv[e] = xv[4 * i + e] * rstd * w[e] * (1.f + s[e]) + a[e];
      u32x2 o = {cvtpk(hv[0], hv[1]), cvtpk(hv[2], hv[3])};
      *reinterpret_cast<u32x2*>(hr + lane * 4 + 256 * i) = o;
    }
  }
}

constexpr int GROW = 144;
constexpr int GTILE = 256 * GROW;
constexpr int GEMM_LDS = 4 * GTILE;
constexpr int GST = 32768;


template <int EPI, int TB>
__device__ __forceinline__ void gemm_epilogue(const Params& p, f32x16 (&acc)[4][TB], int m0, int n0, int t0, bool lat, int layer, char* lds) {
  const int tid = opaque_tid(), wid = tid >> 6, lane = tid & 63, r32 = lane & 31, hi = lane >> 5;
  const int wf = wid & 1, wt = wid >> 1;
  const int nw = n0 + wf * 128;
  if constexpr (EPI == 2) {
    char* const wl = lds + wid * (32 * 272);
#pragma unroll
    for (int tb = 0; tb < TB; ++tb) {
      SBAR();
#pragma unroll
      for (int fb = 0; fb < 4; ++fb)
#pragma unroll
        for (int j = 0; j < 4; ++j) { u32x2 v = {cvtpk(acc[fb][tb][4 * j], acc[fb][tb][4 * j + 1]), cvtpk(acc[fb][tb][4 * j + 2], acc[fb][tb][4 * j + 3])};
          *reinterpret_cast<u32x2*>(wl + r32 * 272 + (fb * 32 + 8 * j + 4 * hi) * 2) = v; }
      asm volatile("s_waitcnt lgkmcnt(0)" ::: "memory"); __builtin_amdgcn_wave_barrier();
      bf16* yb = p.y + (size_t)(m0 + wt * (32 * TB) + tb * 32) * DM + nw;
#pragma unroll
      for (int i = 0; i < 8; ++i) { const int row = 4 * i + (lane >> 4), ch = lane & 15;
        u32x4 v = *reinterpret_cast<const u32x4*>(wl + row * 272 + ch * 16);
        store_wt(yb + (size_t)row * DM + ch * 8, v); }
      asm volatile("s_waitcnt lgkmcnt(0)" ::: "memory"); __builtin_amdgcn_wave_barrier();
    }
  } else {
    constexpr int LD = (EPI == 0) ? NA : NG;
    const bool qk = (EPI == 0) ? (n0 < 2048) : (n0 < 1280);
#pragma unroll
    for (int tb = 0; tb < TB; ++tb) {
      SBAR();
      if constexpr (EPI == 1) {
        if (qk) {
          const float* g = p.b_qk_g + (layer * 2 + (n0 < 1024 ? 0 : 1)) * 128 + hi * 4;
          float ss = 0;
#pragma unroll
          for (int fb = 0; fb < 4; ++fb)
#pragma unroll
            for (int r = 0; r < 16; ++r) ss += acc[fb][tb][r] * acc[fb][tb][r];
          ss += __shfl_xor(ss, 32, 64);
          const float rstd = rsqrtf(ss * (1.f / 128.f) + EPS);
#pragma unroll
          for (int fb = 0; fb < 4; ++fb) {
            SBAR();
#pragma unroll
            for (int j = 0; j < 4; ++j) { const f32x4 gv = *reinterpret_cast<const f32x4*>(g + fb * 32 + 8 * j);
#pragma unroll
              for (int i = 0; i < 4; ++i) acc[fb][tb][4 * j + i] *= rstd * gv[i]; }
          }
        }
      }
      if (qk && lat) {
        const int t = t0 + wt * (32 * TB) + tb * 32 + r32;
        const float prow = (float)(t >> 6), pcol = (float)(t & 63);
        if constexpr (EPI == 0) {
#pragma unroll
          for (int r = 0; r < 16; ++r) {
            SBAR();
            const int fi = (r & 3) + 8 * ((r >> 2) & 1) + 4 * hi;
            const float freq = __builtin_amdgcn_exp2f(-(float)fi * (LOG2_THETA / 16.f));
            float rev = ((r >> 2) < 2 ? prow : pcol) * freq * 0.15915494309189535f; rev -= floorf(rev);
            const float cs = __builtin_amdgcn_cosf(rev), sn = __builtin_amdgcn_sinf(rev);
#pragma unroll
            for (int u = 0; u < 2; ++u) { float x1 = acc[2 * u][tb][r], x2 = acc[2 * u + 1][tb][r];
              acc[2 * u][tb][r] = x1 * cs - x2 * sn; acc[2 * u + 1][tb][r] = x2 * cs + x1 * sn; }
          }
        } else {
#pragma unroll
          for (int r = 0; r < 16; ++r) {
            SBAR();
            const int fi = crow(r, hi);
            const float freq = __builtin_amdgcn_exp2f(-(float)fi * (LOG2_THETA / 32.f)) * 0.15915494309189535f;
            float rv0 = prow * freq; rv0 -= floorf(rv0); float rv1 = pcol * freq; rv1 -= floorf(rv1);
            const float c0 = __builtin_amdgcn_cosf(rv0), s0 = __builtin_amdgcn_sinf(rv0), c1 = __builtin_amdgcn_cosf(rv1), s1 = __builtin_amdgcn_sinf(rv1);
            { float x1 = acc[0][tb][r], x2 = acc[2][tb][r]; acc[0][tb][r] = x1 * c0 - x2 * s0; acc[2][tb][r] = x2 * c0 + x1 * s0; }
            { float x1 = acc[1][tb][r], x2 = acc[3][tb][r]; acc[1][tb][r] = x1 * c1 - x2 * s1; acc[3][tb][r] = x2 * c1 + x1 * s1; }
          }
        }
      }
      SBAR();
      char* const wl = lds + wid * (32 * 272);
#pragma unroll
      for (int fb = 0; fb < 4; ++fb)
#pragma unroll
        for (int j = 0; j < 4; ++j) { u32x2 v = {cvtpk(acc[fb][tb][4 * j], acc[fb][tb][4 * j + 1]), cvtpk(acc[fb][tb][4 * j + 2], acc[fb][tb][4 * j + 3])};
          *reinterpret_cast<u32x2*>(wl + r32 * 272 + (fb * 32 + 8 * j + 4 * hi) * 2) = v; }
      asm volatile("s_waitcnt lgkmcnt(0)" ::: "memory"); __builtin_amdgcn_wave_barrier();
      bf16* ob = p.qkvz + (size_t)(m0 + wt * (32 * TB) + tb * 32) * LD + nw;
#pragma unroll
      for (int i = 0; i < 8; ++i) { const int row = 4 * i + (lane >> 4), ch = lane & 15;
        u32x4 v = *reinterpret_cast<const u32x4*>(wl + row * 272 + ch * 16);
        *reinterpret_cast<u32x4*>(ob + (size_t)row * LD + ch * 8) = v; }
      asm volatile("s_waitcnt lgkmcnt(0)" ::: "memory"); __builtin_amdgcn_wave_barrier();
    }
  }
}

template <int EPI, int TB>
__device__ __forceinline__ void gemm_tile(const Params& p, const bf16* __restrict__ A, const bf16* __restrict__ Wt, int m0, int n0, int layer, char* lds) {
  const int tid = opaque_tid(), wid = tid >> 6, lane = tid & 63, r32 = lane & 31, hi = lane >> 5;
  const int wf = wid & 1, wt = wid >> 1;
  const int mt = m0 >> 8;
  const int t0 = (mt % 33) * 256 + (m0 & 255); const bool lat = (mt % 33) < 32;
  f32x16 acc[4][TB];
#pragma unroll
  for (int i = 0; i < 4; ++i)
#pragma unroll
    for (int tb = 0; tb < TB; ++tb) acc[i][tb] = f32x16{};
  const int gch = (lane & 3) ^ ((lane >> 4) & 3);
  const bf16* Ag = A + (size_t)(m0 + wid * (16 * TB) + (lane >> 2)) * 1024 + gch * 8;
  const bf16* Wg = Wt + (size_t)(n0 + wid * 32 + (lane >> 2)) * 1024 + gch * 8;
  char* const dA = lds + wid * (1024 * TB);
  char* const dW = lds + 16384 + wid * 2048;
#define GISSUE(kt_) do { const int st_ = ((kt_) & 3) * GST; \
      __builtin_amdgcn_global_load_lds((const unsigned*)(Ag + (kt_) * 32), (unsigned*)(dA + st_), 16, 0, 0); \
      if constexpr (TB == 2) __builtin_amdgcn_global_load_lds((const unsigned*)(Ag + 16 * 1024 + (kt_) * 32), (unsigned*)(dA + st_ + 1024), 16, 0, 0); \
      __builtin_amdgcn_global_load_lds((const unsigned*)(Wg + (kt_) * 32), (unsigned*)(dW + st_), 16, 0, 0); \
      __builtin_amdgcn_global_load_lds((const unsigned*)(Wg + 16 * 1024 + (kt_) * 32), (unsigned*)(dW + st_ + 1024), 16, 0, 0); } while (0)
  asm volatile("s_waitcnt vmcnt(0)" ::: "memory");
  GISSUE(0); GISSUE(1); GISSUE(2);
  const int q4 = (r32 >> 2) & 3;
  const int off0 = (hi ^ q4) * 16, off1 = ((2 + hi) ^ q4) * 16;
  const char* const ra = lds + (wt * (32 * TB) + r32) * 64;
  const char* const rw = lds + 16384 + (wf * 128 + r32) * 64;
  for (int kt = 0; kt < 32; ++kt) {
    if constexpr (TB == 2) {
      if (kt < 30) asm volatile("s_waitcnt vmcnt(8)" ::: "memory");
      else if (kt == 30) asm volatile("s_waitcnt vmcnt(4)" ::: "memory");
      else asm volatile("s_waitcnt vmcnt(0)" ::: "memory");
    } else {
      if (kt < 30) asm volatile("s_waitcnt vmcnt(6)" ::: "memory");
      else if (kt == 30) asm volatile("s_waitcnt vmcnt(3)" ::: "memory");
      else asm volatile("s_waitcnt vmcnt(0)" ::: "memory");
    }
    asm volatile("s_waitcnt lgkmcnt(0)" ::: "memory"); __builtin_amdgcn_s_barrier();
    if (kt + 3 < 32) GISSUE(kt + 3);
    const int cur = (kt & 3) * GST;
#pragma unroll
    for (int ks = 0; ks < 2; ++ks) {
      const int ko = ks ? off1 : off0;
      bf16x8 fa[TB], fw[4];
#pragma unroll
      for (int tb = 0; tb < TB; ++tb) fa[tb] = *reinterpret_cast<const bf16x8*>(ra + cur + tb * 32 * 64 + ko);
#pragma unroll
      for (int fb = 0; fb < 4; ++fb) fw[fb] = *reinterpret_cast<const bf16x8*>(rw + cur + fb * 32 * 64 + ko);
#pragma unroll
      for (int fb = 0; fb < 4; ++fb)
#pragma unroll
        for (int tb = 0; tb < TB; ++tb) acc[fb][tb] = __builtin_amdgcn_mfma_f32_32x32x16_bf16(fw[fb], fa[tb], acc[fb][tb], 0, 0, 0);
    }
  }
#undef GISSUE
  asm volatile("s_waitcnt lgkmcnt(0)" ::: "memory"); __builtin_amdgcn_s_barrier();
  gemm_epilogue<EPI, TB>(p, acc, m0, n0, t0, lat, layer, lds);
  if constexpr (EPI == 2) asm volatile("s_waitcnt vmcnt(0)" ::: "memory");
  __syncthreads();
  if constexpr (EPI == 2) { if (tid == 0) __hip_atomic_fetch_add(p.cnt + layer * 132 + mt, (unsigned)TB, __ATOMIC_RELEASE, __HIP_MEMORY_SCOPE_AGENT); }
}

template <int EPI>
__device__ __forceinline__ void gemm_phase(const Params& p, const bf16* __restrict__ A, const bf16* __restrict__ Wt, int N, int layer, bool skip_ctx, char* lds) {
  const int nN = N / 256, nM = skip_ctx ? 128 : 132, ntiles = nM * nN;
  const int GMT = (nN == 4) ? 8 : 4, gtiles = GMT * nN;
  const int G = gridDim.x, bid = blockIdx.x;
  auto tile_mn = [&](int L, int& m0, int& n0) {
    const int grp = L / gtiles, qi = L % gtiles, gsz = min(GMT, nM - grp * GMT);
    const int nt = qi / gsz, lm = grp * GMT + qi % gsz, mt = skip_ctx ? lm + (lm >> 5) : lm;
    m0 = mt * 256; n0 = nt * 256;
  };
  const int nfull = ntiles / G;
  for (int rnd = 0; rnd < nfull; ++rnd) {
    const int L = (G == 256) ? (rnd * 8 + (bid & 7)) * 32 + (bid >> 3) : rnd * G + bid;
    int m0, n0; tile_mn(L, m0, n0);
    gemm_tile<EPI, 2>(p, A, Wt, m0, n0, layer, lds);
  }
  const int left = ntiles - nfull * G;
  for (int u = bid; u < 2 * left; u += G) {
    int m0, n0; tile_mn(nfull * G + (u >> 1), m0, n0);
    gemm_tile<EPI, 1>(p, A, Wt, m0 + (u & 1) * 128, n0, layer, lds);
  }
}

constexpr int KVBLK = 64;
constexpr size_t SHM_V = KVBLK * 128 * 2, SHM_K = KVBLK * 128 * 2, SHM_ATTN = 3 * SHM_V + 3 * SHM_K + 8 * 64 * 4;
constexpr float THR = 8.f;
#define KSWZ(row, colB) ((row) * 256 + ((colB) ^ (((row) & 7) << 4)))

template <int MODE> struct AM;
template <> struct AM<0> { static constexpr int LD = NA, ND0 = 4; static constexpr float SCALE = 0.125f; };
template <> struct AM<1> { static constexpr int LD = NG, ND0 = 8; static constexpr float SCALE = 0.088388347648318440f; };

template <int MODE>
__device__ __forceinline__ void partialSM(f32x16& p0, f32x16& p1, float& m_reg, float& mn, float& alpha) {
  constexpr float SCALE = AM<MODE>::SCALE;
  constexpr float C = SCALE * 1.4426950408889634f;
  float pmax = p0[0];
#pragma unroll
  for (int r = 1; r < 16; ++r) pmax = fmaxf(pmax, p0[r]);
#pragma unroll
  for (int r = 0; r < 16; ++r) pmax = fmaxf(pmax, p1[r]);
  { auto rr = __builtin_amdgcn_permlane32_swap(__float_as_uint(pmax), __float_as_uint(pmax), false, false);
    pmax = fmaxf(__uint_as_float(rr[0]), __uint_as_float(rr[1])); }
  if (__builtin_expect(__all(pmax - m_reg <= THR / SCALE), 1)) { mn = m_reg; alpha = 1.f; }
  else { mn = fmaxf(m_reg, pmax); alpha = __builtin_amdgcn_exp2f((m_reg - mn) * C); m_reg = mn; }
  float mnC = -mn * C;
#pragma unroll
  for (int r = 0; r < 16; ++r) p0[r] = fmaf(p0[r], C, mnC);
#pragma unroll
  for (int r = 0; r < 16; ++r) p1[r] = fmaf(p1[r], C, mnC);
#pragma unroll
  for (int r = 0; r < 16; ++r) p0[r] = __builtin_amdgcn_exp2f(p0[r]);
}
__device__ __forceinline__ void finishSM(f32x16& p0, f32x16& p1, float alpha, float& l_reg, bf16x8& pa0, bf16x8& pa1, bf16x8& pa2, bf16x8& pa3) {
#pragma unroll
  for (int r = 0; r < 16; ++r) p1[r] = __builtin_amdgcn_exp2f(p1[r]);
  float ps = 0;
#pragma unroll
  for (int r = 0; r < 16; ++r) ps += p0[r];
#pragma unroll
  for (int r = 0; r < 16; ++r) ps += p1[r];
  { auto rr = __builtin_amdgcn_permlane32_swap(__float_as_uint(ps), __float_as_uint(ps), false, false);
    ps = __uint_as_float(rr[0]) + __uint_as_float(rr[1]); }
  l_reg = l_reg * alpha + ps;
#define PK4(P, BASE, OUT) do { unsigned a0 = cvtpk(P[BASE + 0], P[BASE + 1]), a1 = cvtpk(P[BASE + 2], P[BASE + 3]);   \
    unsigned b0 = cvtpk(P[BASE + 4], P[BASE + 5]), b1 = cvtpk(P[BASE + 6], P[BASE + 7]);                              \
    auto r0 = __builtin_amdgcn_permlane32_swap(a0, b0, false, false); auto r1 = __builtin_amdgcn_permlane32_swap(a1, b1, false, false); \
    u32x4 w = {r0[0], r1[0], r0[1], r1[1]}; OUT = *reinterpret_cast<bf16x8*>(&w); } while (0)
  PK4(p0, 0, pa0); PK4(p0, 8, pa1); PK4(p1, 0, pa2); PK4(p1, 8, pa3);
#undef PK4
}
template <int MODE>
__device__ __forceinline__ void qkt(f32x16& p0, f32x16& p1, const bf16* Ks, const bf16x8* qr, int r32, int hi, int coff) {
  p0 = f32x16{}; p1 = f32x16{};
#pragma unroll
  for (int d0 = 0; d0 < AM<MODE>::ND0; ++d0) { int cb = (coff + d0 * 16 + hi * 8) * 2;
    bf16x8 b0 = *reinterpret_cast<const bf16x8*>((const char*)Ks + KSWZ(r32, cb));
    bf16x8 b1 = *reinterpret_cast<const bf16x8*>((const char*)Ks + KSWZ(32 + r32, cb));
    p0 = __builtin_amdgcn_mfma_f32_32x32x16_bf16(b0, qr[d0], p0, 0, 0, 0);
    p1 = __builtin_amdgcn_mfma_f32_32x32x16_bf16(b1, qr[d0], p1, 0, 0, 0); }
}
__device__ __forceinline__ int v_st(int k, int c) { const int kk = (k & ~0xC) | ((k & 4) << 1) | ((k & 8) >> 1); return ((kk >> 3) * 4 + (c >> 5)) * 512 + ((kk & 7) * 32 + (c & 31)) * 2; }
__device__ __forceinline__ int v_rd_base(int lane) { return ((lane & 3) << 3) | (((lane >> 2) & 3) << 6) | (((lane >> 4) & 1) << 5) | (((lane >> 5) & 1) << 8); }
constexpr int v_rd_off(int d0, int ks, int half) { return d0 * 512 + ks * 4096 + half * 2048; }
template <int OFF> __device__ __forceinline__ s16x4 tr_read(int vb) {
  s16x4 r; asm volatile("ds_read_b64_tr_b16 %0, %1 offset:%2" : "=&v"(r) : "v"(vb), "i"(OFF) : "memory"); return r;
}
template <int D0> __device__ __forceinline__ void pv_one(f32x16& od, int vb, bf16x8 pa0, bf16x8 pa1, bf16x8 pa2, bf16x8 pa3) {
  const s16x4 l0 = tr_read<v_rd_off(D0, 0, 0)>(vb), h0 = tr_read<v_rd_off(D0, 0, 1)>(vb), l1 = tr_read<v_rd_off(D0, 1, 0)>(vb), h1 = tr_read<v_rd_off(D0, 1, 1)>(vb);
  const s16x4 l2 = tr_read<v_rd_off(D0, 2, 0)>(vb), h2 = tr_read<v_rd_off(D0, 2, 1)>(vb), l3 = tr_read<v_rd_off(D0, 3, 0)>(vb), h3 = tr_read<v_rd_off(D0, 3, 1)>(vb);
  asm volatile("s_waitcnt lgkmcnt(0)" ::: "memory"); SBAR();
#define PK(L, H) (bf16x8){L[0], L[1], L[2], L[3], H[0], H[1], H[2], H[3]}
  od = __builtin_amdgcn_mfma_f32_32x32x16_bf16(pa0, PK(l0, h0), od, 0, 0, 0);
  od = __builtin_amdgcn_mfma_f32_32x32x16_bf16(pa1, PK(l1, h1), od, 0, 0, 0);
  od = __builtin_amdgcn_mfma_f32_32x32x16_bf16(pa2, PK(l2, h2), od, 0, 0, 0);
  od = __builtin_amdgcn_mfma_f32_32x32x16_bf16(pa3, PK(l3, h3), od, 0, 0, 0);
#undef PK
}
__device__ __forceinline__ void pv_d0(f32x16* o, int vb, bf16x8 pa0, bf16x8 pa1, bf16x8 pa2, bf16x8 pa3) {
  pv_one<0>(o[0], vb, pa0, pa1, pa2, pa3); pv_one<1>(o[1], vb, pa0, pa1, pa2, pa3); pv_one<2>(o[2], vb, pa0, pa1, pa2, pa3); pv_one<3>(o[3], vb, pa0, pa1, pa2, pa3);
}
template <int MODE>
__device__ __forceinline__ void pv_sm(f32x16* o, int vb, bf16x8 pa0, bf16x8 pa1, bf16x8 pa2, bf16x8 pa3, f32x16& p0, f32x16& p1, float& m_reg, float& mn, float& alpha) {
  constexpr float SCALE = AM<MODE>::SCALE;
  constexpr float C = SCALE * 1.4426950408889634f;
  pv_one<0>(o[0], vb, pa0, pa1, pa2, pa3);
  float pmax = p0[0];
#pragma unroll
  for (int r = 1; r < 16; ++r) pmax = fmaxf(pmax, p0[r]);
#pragma unroll
  for (int r = 0; r < 16; ++r) pmax = fmaxf(pmax, p1[r]);
  { auto rr = __builtin_amdgcn_permlane32_swap(__float_as_uint(pmax), __float_as_uint(pmax), false, false);
    pmax = fmaxf(__uint_as_float(rr[0]), __uint_as_float(rr[1])); }
  const bool keep = __all(pmax - m_reg <= THR / SCALE);
  mn = keep ? m_reg : fmaxf(m_reg, pmax);
  alpha = keep ? 1.f : __builtin_amdgcn_exp2f((m_reg - mn) * C);
  m_reg = mn;
  const float mnC = -mn * C;
  pv_one<1>(o[1], vb, pa0, pa1, pa2, pa3);
#pragma unroll
  for (int r = 0; r < 16; ++r) p0[r] = fmaf(p0[r], C, mnC);
#pragma unroll
  for (int r = 0; r < 16; ++r) p1[r] = fmaf(p1[r], C, mnC);
  asm volatile("" : "+v"(p0), "+v"(p1));
  pv_one<2>(o[2], vb, pa0, pa1, pa2, pa3);
#pragma unroll
  for (int r = 0; r < 8; ++r) p0[r] = __builtin_amdgcn_exp2f(p0[r]);
  asm volatile("" : "+v"(p0));
  pv_one<3>(o[3], vb, pa0, pa1, pa2, pa3);
#pragma unroll
  for (int r = 8; r < 16; ++r) p0[r] = __builtin_amdgcn_exp2f(p0[r]);
  asm volatile("" : "+v"(p0));
  SBAR();
}

template <int MODE>
__device__ __forceinline__ void epilogue(f32x16* o, const float* rli, const bf16* __restrict__ Zb, bf16* __restrict__ Ob, char* lds, float lam, float osc, const float* __restrict__ subg);
template <int MODE>
__device__ __forceinline__ void attn_body(const bf16* __restrict__ Qb, const bf16* __restrict__ Kh, const bf16* __restrict__ Vh,
                                          const bf16* __restrict__ Zb, bf16* __restrict__ Ob, int seq, char* lds,
                                          float lam, float osc, const float* __restrict__ subg) {
  constexpr int LD = AM<MODE>::LD, ND0 = AM<MODE>::ND0;
  const int tid = opaque_tid(), wid = tid >> 6, lane = tid & 63, r32 = lane & 31, hi = lane >> 5;
  const int qw = (MODE == 0) ? (wid & 3) : wid;
  const int half = (MODE == 0) ? (wid >> 2) : 0;
  const int coff = half * 64;
  bf16* V_lds = (bf16*)lds; bf16* K_lds = (bf16*)(lds + 3 * SHM_V);
  float* ws = (float*)(lds + 3 * SHM_V + 3 * SHM_K) + wid * 64; float* li_l = ws; float* al_l = ws + 32;
  float m_reg = -1e30f, l_reg = 0; f32x16 o[4] = {}; bf16x8 qr[ND0];
  const bf16* Qw = Qb + (long)(qw * 32 + r32) * LD + coff + hi * 8;
#pragma unroll
  for (int d0 = 0; d0 < ND0; ++d0) qr[d0] = *reinterpret_cast<const bf16x8*>(Qw + d0 * 16);
  const int sr = tid >> 4, sc = (tid & 15) * 8, vst0 = v_st(sr, sc), vst1 = v_st(32 + sr, sc);
  const int vb0 = (int)(uintptr_t)V_lds + v_rd_base(lane);
  struct { bf16x8 vs0, vs1, ks0, ks1; } sr_[2];
#define SLOAD(i, k0) do { sr_[i].vs0 = *reinterpret_cast<const bf16x8*>(&Vh[(long)((k0) + sr) * LD + sc]); sr_[i].vs1 = *reinterpret_cast<const bf16x8*>(&Vh[(long)((k0) + 32 + sr) * LD + sc]); \
    sr_[i].ks0 = *reinterpret_cast<const bf16x8*>(&Kh[(long)((k0) + sr) * LD + sc]); sr_[i].ks1 = *reinterpret_cast<const bf16x8*>(&Kh[(long)((k0) + 32 + sr) * LD + sc]); } while (0)
#define SWRITE(b, i) do { *(bf16x8*)((char*)V_lds + (b) * SHM_V + vst0) = sr_[i].vs0;          \
    *(bf16x8*)((char*)V_lds + (b) * SHM_V + vst1) = sr_[i].vs1; int kc = sc * 2;               \
    *(bf16x8*)((char*)K_lds + (b) * SHM_K + KSWZ(sr, kc)) = sr_[i].ks0;                       \
    *(bf16x8*)((char*)K_lds + (b) * SHM_K + KSWZ(32 + sr, kc)) = sr_[i].ks1; } while (0)
#define SWAIT() asm volatile("s_waitcnt vmcnt(4)" ::: "memory")
#define RESC(a) do { if (__any((a) < 1.f)) { if (hi == 0) al_l[r32] = (a); asm volatile("s_waitcnt lgkmcnt(0)" ::: "memory"); \
    _Pragma("unroll") for (int d = 0; d < 4; ++d) _Pragma("unroll") for (int r = 0; r < 16; ++r) o[d][r] *= al_l[crow(r, hi)]; } } while (0)
  f32x16 pA0, pA1, pB0, pB1; float mnA, mnB, alA, alB; bf16x8 pa0, pa1, pa2, pa3; const int NT = seq / KVBLK;
  constexpr int SE = 0, SO = 1;
  SLOAD(SE, 0); asm volatile("s_waitcnt vmcnt(0)" ::: "memory"); SWRITE(0, SE); __syncthreads();
  qkt<MODE>(pA0, pA1, K_lds, qr, r32, hi, coff); partialSM<MODE>(pA0, pA1, m_reg, mnA, alA);
  SLOAD(SO, KVBLK); if (2 < NT) SLOAD(SE, 2 * KVBLK);
  SWAIT(); SWRITE(1, SO); __syncthreads();
  int bP = 0, bC = 1, bN = 2;
  for (int j = 1; j + 1 < NT; j += 2) {
    SBAR(); qkt<MODE>(pB0, pB1, (bf16*)((char*)K_lds + bC * SHM_K), qr, r32, hi, coff);
    finishSM(pA0, pA1, alA, l_reg, pa0, pa1, pa2, pa3); SBAR();
    SLOAD(SO, (j + 2) * KVBLK); SBAR();
    pv_sm<MODE>(o, vb0 + bP * (int)SHM_V, pa0, pa1, pa2, pa3, pB0, pB1, m_reg, mnB, alB);
    SWAIT(); SWRITE(bN, SE);
    RESC(alB); __syncthreads();
    { const int t_ = bP; bP = bC; bC = bN; bN = t_; }
    SBAR(); qkt<MODE>(pA0, pA1, (bf16*)((char*)K_lds + bC * SHM_K), qr, r32, hi, coff);
    finishSM(pB0, pB1, alB, l_reg, pa0, pa1, pa2, pa3); SBAR();
    if (j + 3 < NT) SLOAD(SE, (j + 3) * KVBLK); SBAR();
    pv_sm<MODE>(o, vb0 + bP * (int)SHM_V, pa0, pa1, pa2, pa3, pA0, pA1, m_reg, mnA, alA);
    SWAIT(); SWRITE(bN, SO);
    RESC(alA); __syncthreads();
    { const int t_ = bP; bP = bC; bC = bN; bN = t_; }
  }
  SBAR(); qkt<MODE>(pB0, pB1, (bf16*)((char*)K_lds + bC * SHM_K), qr, r32, hi, coff);
  finishSM(pA0, pA1, alA, l_reg, pa0, pa1, pa2, pa3); SBAR();
  pv_d0(o, vb0 + bP * (int)SHM_V, pa0, pa1, pa2, pa3); partialSM<MODE>(pB0, pB1, m_reg, mnB, alB);
  RESC(alB);
  finishSM(pB0, pB1, alB, l_reg, pa0, pa1, pa2, pa3); SBAR();
  pv_d0(o, vb0 + bC * (int)SHM_V, pa0, pa1, pa2, pa3);
  if (hi == 0) li_l[r32] = l_reg; asm volatile("s_waitcnt lgkmcnt(0)" ::: "memory");
  float rli[16];
#pragma unroll
  for (int r = 0; r < 16; ++r) rli[r] = __builtin_amdgcn_rcpf(li_l[crow(r, hi)]);
  __syncthreads();
  epilogue<MODE>(o, rli, Zb, Ob, lds, lam, osc, subg);
}

template <int MODE>
__device__ __forceinline__ void epilogue(f32x16* o, const float* rli, const bf16* __restrict__ Zb, bf16* __restrict__ Ob, char* lds, float lam, float osc, const float* __restrict__ subg) {
  constexpr int LD = AM<MODE>::LD;
  const int tid = opaque_tid(), wid = tid >> 6, lane = tid & 63, r32 = lane & 31, hi = lane >> 5;
  float* const Y = (float*)lds;
#pragma unroll
  for (int r = 0; r < 16; ++r) { float* yr = Y + (wid * 32 + crow(r, hi)) * 132 + r32;
#pragma unroll
    for (int d0 = 0; d0 < 4; ++d0) yr[d0 * 32] = o[d0][r] * rli[r]; }
  if constexpr (MODE == 1) { asm volatile("s_waitcnt lgkmcnt(0)" ::: "memory"); __builtin_amdgcn_wave_barrier(); }
  else __syncthreads();
  const int c = lane & 15, rsub = lane >> 4;
  constexpr int NIT = (MODE == 1) ? 8 : 4;
  float sg[8];
  if constexpr (MODE == 0) {
#pragma unroll
    for (int e = 0; e < 8; ++e) sg[e] = subg[c * 8 + e] * osc;
  }
#pragma unroll
  for (int i = 0; i < NIT; ++i) {
    SBAR();
    const int row = ((MODE == 1) ? wid * 32 : wid * 16) + i * 4 + rsub;
    const f32x4 a0 = *reinterpret_cast<const f32x4*>(Y + row * 132 + c * 8), a1 = *reinterpret_cast<const f32x4*>(Y + row * 132 + c * 8 + 4);
    float v[8] = {a0[0], a0[1], a0[2], a0[3], a1[0], a1[1], a1[2], a1[3]};
    const u32x4 zz = *reinterpret_cast<const u32x4*>(Zb + (long)row * LD + c * 8);
    if constexpr (MODE == 0) {
      const f32x4 b0 = *reinterpret_cast<const f32x4*>(Y + (128 + row) * 132 + c * 8), b1 = *reinterpret_cast<const f32x4*>(Y + (128 + row) * 132 + c * 8 + 4);
      const float w[8] = {b0[0], b0[1], b0[2], b0[3], b1[0], b1[1], b1[2], b1[3]};
      float ss = 0;
#pragma unroll
      for (int e = 0; e < 8; ++e) { v[e] -= lam * w[e]; ss += v[e] * v[e]; }
#pragma unroll
      for (int sft = 8; sft > 0; sft >>= 1) ss += __shfl_xor(ss, sft, 64);
      const float rstd = rsqrtf(ss * (1.f / 128.f) + EPS);
#pragma unroll
      for (int e = 0; e < 8; ++e) v[e] *= rstd * sg[e];
    }
#pragma unroll
    for (int e = 0; e < 4; ++e) { v[2 * e] *= silu_f(__uint_as_float(zz[e] << 16)); v[2 * e + 1] *= silu_f(__uint_as_float(zz[e] & 0xffff0000u)); }
    const u32x4 ov = {cvtpk(v[0], v[1]), cvtpk(v[2], v[3]), cvtpk(v[4], v[5]), cvtpk(v[6], v[7])};
    *reinterpret_cast<u32x4*>(Ob + (long)row * DM + c * 8) = ov;
  }
  __syncthreads();
#undef SLOAD
#undef SWRITE
#undef SWAIT
#undef RESC
}

__device__ __forceinline__ void attn_phase_da(const Params& p, int layer, char* lds) {
  const int j = layer >> 1; const bool last = (layer == DEPTH - 1);
  const float lam_init = 0.8f - 0.6f * __expf(-0.3f * (float)layer);
  const float* lp = p.a_lambda + j * 4 * 64;
  float s1 = 0, s2 = 0;
  for (int e = 0; e < 64; ++e) { s1 += lp[e] * lp[64 + e]; s2 += lp[128 + e] * lp[192 + e]; }
  const float lam = __expf(s1) - __expf(s2) + lam_init;
  const float* subg = p.a_subln_g + j * 128;
  const bf16* base = p.qkvz; bf16* og = p.h;
  const int bid = blockIdx.x, G = gridDim.x;
  const int nit = last ? 2048 : 2048 + 64;
  for (int it = bid; it < nit; it += G) {
    int grp, qb, seq; long R0, K0;
    if (it < 2048) {
      if (G == 256) { const int rnd = it >> 8, xcd = bid & 7, slot = bid >> 3; grp = xcd + 8 * (rnd >> 1); qb = (rnd & 1) * 32 + slot; }
      else { grp = it >> 6; qb = it & 63; }
      K0 = (long)(grp >> 3) * TOK; R0 = K0 + qb * 128; seq = TOK;
    } else { const int u = it - 2048; grp = u >> 1; qb = u & 1; K0 = (long)(grp >> 3) * TOK + SEQ; R0 = K0 + qb * 128; seq = CTX; }
    const int hd = grp & 7;
    attn_body<0>(base + R0 * NA + hd * 128, base + K0 * NA + 1024 + hd * 128, base + K0 * NA + 2048 + hd * 128,
                 base + R0 * NA + 3072 + hd * 128, og + R0 * DM + hd * 128, seq, lds, lam, 1.f - lam_init, subg);
  }
}
__device__ __forceinline__ void attn_phase_gq(const Params& p, int layer, char* lds) {
  const bool last = (layer == DEPTH - 1);
  const bf16* base = p.qkvz; bf16* og = p.h;
  const int bid = blockIdx.x, G = gridDim.x;
  const int nit = last ? 1024 : 1024 + 32;
  for (int it = bid; it < nit; it += G) {
    int b, hd, seq; long R0, K0;
    if (it < 1024) {
      int grp, idx;
      if (G == 256) { const int rnd = it >> 8; grp = bid & 7; idx = rnd * 32 + (bid >> 3); }
      else { grp = it >> 7; idx = it & 127; }
      b = grp >> 1; hd = (grp & 1) * 4 + (idx >> 5); K0 = (long)b * TOK; R0 = K0 + (idx & 31) * 256; seq = TOK;
    } else { const int u = it - 1024; b = u >> 3; hd = u & 7; K0 = (long)b * TOK + SEQ; R0 = K0; seq = CTX; }
    const int kvh = hd >> 2;
    attn_body<1>(base + R0 * NG + hd * 128, base + K0 * NG + 1024 + kvh * 128, base + K0 * NG + 1280 + kvh * 128,
                 base + R0 * NG + 1536 + hd * 128, og + R0 * DM + hd * 128, seq, lds, 0.f, 0.f, nullptr);
  }
}

__global__ __launch_bounds__(NTHR) void mega(Params p) {
  extern __shared__ __attribute__((aligned(16))) char lds[];
  if (blockIdx.x == 0 && threadIdx.x == 0) __hip_atomic_store(p.bar, 0u, __ATOMIC_RELAXED, __HIP_MEMORY_SCOPE_AGENT);
  if (blockIdx.x == 0) { for (int i = threadIdx.x; i < DEPTH * 132; i += NTHR) __hip_atomic_store(p.cnt + i, 0u, __ATOMIC_RELAXED, __HIP_MEMORY_SCOPE_AGENT); }
  unsigned nbar = 0;
  for (int ph = p.phase_lo; ph < p.phase_hi; ++ph) {
    if (ph >= 2 && ((ph - 2) & 3) == 3) continue;
    if (ph == p.phase_lo + 1) cg::this_grid().sync();
    else if (ph > p.phase_lo) { ++nbar; grid_bar(p.bar, nbar * gridDim.x); }
    if (ph == 0) { for (int rep = 0; rep < REP_PREP; ++rep) { if (rep) cg::this_grid().sync(); phase_prep(p, lds); }
                   for (int rep = 0; rep < REP_SYNC; ++rep) cg::this_grid().sync(); }
    else if (ph == 1) phase_rows(p, -1);
    else {
      const int layer = (ph - 2) >> 2, sub = (ph - 2) & 3, j = layer >> 1; const bool da = (layer & 1) == 0;
      if (sub == 0) { for (int rep = 0; rep < REP_GEMM; ++rep) { if (rep) cg::this_grid().sync();
                      if (da) gemm_phase<0>(p, p.h, p.wtA + (size_t)j * NA * 1024, NA, j, false, lds);
                      else    gemm_phase<1>(p, p.h, p.wtB + (size_t)j * NG * 1024, NG, j, false, lds); } }
      else if (sub == 1) { for (int rep = 0; rep < REP_ATTN; ++rep) { if (rep) cg::this_grid().sync();
                      if (da) attn_phase_da(p, layer, lds); else attn_phase_gq(p, layer, lds); } }
      else if (sub == 2) { gemm_phase<2>(p, p.h, p.wtO + (size_t)layer * DM * 1024, DM, layer, layer == DEPTH - 1, lds);
                           __syncthreads(); phase_rows(p, layer, false, p.cnt + layer * 132); }
      else { for (int rep = REP_ROWS - 1; rep >= 0; --rep) { phase_rows(p, layer, rep > 0); if (rep) cg::this_grid().sync(); } }
    }
  }
}

extern "C" void kernel_launch(void* const* d_in, const int* in_sizes, int n_in, void* d_out, int out_size, void* d_ws, size_t ws_size, hipStream_t stream) {
  constexpr size_t DYN = GEMM_LDS > SHM_ATTN ? GEMM_LDS : SHM_ATTN;
  static int grid_blocks = 0;
  if (!grid_blocks) {
    if (hipFuncSetAttribute((const void*)mega, hipFuncAttributeMaxDynamicSharedMemorySize, (int)DYN) != hipSuccess) { fprintf(stderr, "hipFuncSetAttribute failed\n"); return; }
    int dev = 0, cus = 0, per_cu = 0;
    hipGetDevice(&dev);
    hipDeviceGetAttribute(&cus, hipDeviceAttributeMultiprocessorCount, dev);
    hipOccupancyMaxActiveBlocksPerMultiprocessor(&per_cu, mega, NTHR, DYN);
    if (per_cu < 1) { fprintf(stderr, "occupancy 0\n"); return; }
    grid_blocks = cus;
  }
  Params p{};
  p.x = (const float*)d_in[0]; p.c = (const float*)d_in[1]; p.ctx = (const float*)d_in[2]; p.c_ctx = (const float*)d_in[3];
  p.ada_w = (const float*)d_in[4]; p.ada_b = (const float*)d_in[5]; p.pre_g = (const float*)d_in[6]; p.post_g = (const float*)d_in[7];
  p.w_out = (const float*)d_in[8]; p.a_w_in = (const float*)d_in[9]; p.a_lambda = (const float*)d_in[10]; p.a_subln_g = (const float*)d_in[11];
  p.b_w_in = (const float*)d_in[12]; p.b_qk_g = (const float*)d_in[13];
  p.out = (float*)d_out;
  char* w = (char*)d_ws; size_t off = 0;
  auto take = [&](size_t bytes) { char* r = w + off; off += (bytes + 255) / 256 * 256; return r; };
  p.bar  = (unsigned*)take(256);
  p.cnt  = (unsigned*)take((size_t)DEPTH * 132 * 4);
  p.mods = (float*)take((size_t)DEPTH * 5 * 3072 * 4);
  p.xc   = (float*)take((size_t)NB * CTX * DM * 4);
  p.wtA  = (bf16*)take((size_t)2 * NA * 1024 * 2);
  p.wtB  = (bf16*)take((size_t)2 * NG * 1024 * 2);
  p.wtO  = (bf16*)take((size_t)4 * DM * 1024 * 2);
  p.h    = (bf16*)take((size_t)NROW * DM * 2);
  p.qkvz = (bf16*)take((size_t)NROW * NA * 2);
  p.y    = p.qkvz;
  if (off > ws_size) { fprintf(stderr, "workspace too small: need %zu have %zu\n", off, ws_size); return; }
#if MK_COOP
  p.phase_lo = 0; p.phase_hi = NPHASE;
  void* args[] = {&p};
  hipError_t e = hipLaunchCooperativeKernel((void*)mega, dim3(grid_blocks), dim3(NTHR), args, DYN, stream);
  if (e != hipSuccess) fprintf(stderr, "cooperative launch failed: %s (grid %d)\n", hipGetErrorString(e), grid_blocks);
#else
  for (int ph = 0; ph < NPHASE; ++ph) {
    p.phase_lo = ph; p.phase_hi = ph + 1;
    hipLaunchKernelGGL(mega, dim3(grid_blocks), dim3(NTHR), DYN, stream, p);
  }
#endif
}
```
